# Optimizing an MI355X kernel written in HIP

```python
import jax, jax.numpy as jnp
from jax import lax
import numpy as np

D_MODEL = 1024
BATCH = 16
SEQ = 256
DEPTH = 4
DEC_BATCH = 4
DEC_SEQ = 2048
PAST_LEN = 512

GRID_W = 64
HEAD_DIM = 128
A_HEADS = 4
A_WIDTH = A_HEADS * HEAD_DIM
CHUNK = 64
CONV_K = 3
B_HEADS = 4
B_KV_HEADS = 2
B_WIDTH = B_HEADS * HEAD_DIM
WINDOW = 128
C_HEADS = 8
C_KV_HEADS = 2
C_WIDTH = C_HEADS * HEAD_DIM
BLOCK = 128
D_FF = 4 * D_MODEL
ROT_HALF = HEAD_DIM // 2
ROT_FREQS = ROT_HALF // 2
ROPE_THETA = 10000.0
EPS = 1e-6
NEG = -1e30
N_EVEN = (DEPTH + 1) // 2
N_ODD = DEPTH // 2
EVEN_IN = 4 * A_WIDTH + 4 * A_HEADS + B_WIDTH + 2 * B_KV_HEADS * HEAD_DIM
EVEN_SPLITS = (3 * A_WIDTH, 4 * A_WIDTH, 4 * A_WIDTH + 4 * A_HEADS, 4 * A_WIDTH + 4 * A_HEADS + B_WIDTH)
ODD_IN = C_WIDTH + 2 * C_KV_HEADS * HEAD_DIM
ODD_SPLITS = (C_WIDTH, C_WIDTH + C_KV_HEADS * HEAD_DIM)
F32 = jnp.float32

kernel_name = 'hybrid_deltanet_swa_qknorm_dit_step'


def _rms(x, g):
    xf = x.astype(F32)
    y = xf * lax.rsqrt(jnp.mean(xf * xf, axis=-1, keepdims=True) + EPS)
    return (y * g.astype(F32)).astype(x.dtype)


def _l2norm(x):
    return x * lax.rsqrt(jnp.sum(x * x, axis=-1, keepdims=True) + EPS)


def _adaln(cond, w, b):
    m = jax.nn.silu(cond) @ w + b
    return jnp.split(m[:, None, :], 6, axis=-1)


def _modulate(x, g, shift, scale):
    return _rms(x, g) * (1 + scale) + shift


def _mlp(h, w1, w2):
    return jnp.square(jax.nn.relu(h @ w1)) @ w2


def _short_conv(x, w):
    return lax.conv_general_dilated(x, w[:, None, :].astype(x.dtype), (1,), [(CONV_K // 2, CONV_K // 2)],
                                    dimension_numbers=('NWC', 'WIO', 'NWC'), feature_group_count=x.shape[-1])


def _axial_rope_tables(L):
    rows = L // GRID_W
    row = jnp.repeat(jnp.arange(rows, dtype=F32), GRID_W)
    col = jnp.tile(jnp.arange(GRID_W, dtype=F32), rows)
    inv = ROPE_THETA ** (-jnp.arange(ROT_FREQS, dtype=F32) / ROT_FREQS)
    ang = jnp.stack([row, col], axis=-1)[:, :, None] * inv
    return jnp.cos(ang)[:, None], jnp.sin(ang)[:, None]


def _rope(x, cos, sin):
    Bn, L, H, D = x.shape
    xr = x.reshape(Bn, L, H, 2, 2, ROT_FREQS).astype(F32)
    x1, x2 = xr[..., 0, :], xr[..., 1, :]
    out = jnp.stack([x1 * cos - x2 * sin, x2 * cos + x1 * sin], axis=-2)
    return out.reshape(Bn, L, H, D).astype(x.dtype)


def _group(q, n_kv):
    Bn, L, H, D = q.shape
    return q.reshape(Bn, L, n_kv, H // n_kv, D)


def _attn_blocked(q, k, v, sink):
    Bn, L, KV, G, D = q.shape
    nb = L // BLOCK
    qb = jnp.moveaxis(q.reshape(Bn, nb, BLOCK, KV, G, D), 1, 0)

    def one_block(qi):
        s = jnp.einsum('bqkgd,bmkd->bkgqm', qi, k, preferred_element_type=F32)
        if sink is not None:
            col = jnp.broadcast_to(sink.astype(F32)[None, :, :, None, None], s.shape[:-1] + (1,))
            p = jax.nn.softmax(jnp.concatenate([col, s], axis=-1), axis=-1)[..., 1:]
        else:
            p = jax.nn.softmax(s, axis=-1)
        return jnp.einsum('bkgqm,bmkd->bqkgd', p.astype(v.dtype), v)

    o = lax.map(one_block, qb)
    return jnp.moveaxis(o, 0, 1).reshape(Bn, L, KV * G * D)


def _banded_attn(q, k, v, ck, cv, sink):
    Bn, L, KV, G, D = q.shape
    nb = L // BLOCK
    P = ck.shape[1]
    qb = q.reshape(Bn, nb, BLOCK, KV, G, D)
    pad = lambda t: jnp.pad(t.reshape(Bn, nb, BLOCK, KV, D), ((0, 0), (1, 1), (0, 0), (0, 0), (0, 0)))
    band = lambda t: jnp.concatenate([t[:, :-2], t[:, 1:-1], t[:, 2:]], axis=2)
    kband, vband = band(pad(k)), band(pad(v))
    qpos = jnp.arange(nb)[:, None] * BLOCK + jnp.arange(BLOCK)[None, :]
    kpos = jnp.arange(nb)[:, None] * BLOCK + jnp.arange(-BLOCK, 2 * BLOCK)[None, :]
    valid = ((jnp.abs(qpos[:, :, None] - kpos[:, None, :]) <= WINDOW)
             & (kpos >= 0)[:, None, :] & (kpos < L)[:, None, :])
    s_loc = jnp.einsum('bnqkgd,bnmkd->bnkgqm', qb, kband, preferred_element_type=F32)
    s_loc = jnp.where(valid[None, :, None, None], s_loc, NEG)
    s_ctx = jnp.einsum('bnqkgd,bpkd->bnkgqp', qb, ck, preferred_element_type=F32)
    s_sink = jnp.broadcast_to(sink.astype(F32)[None, None, :, :, None, None], s_loc.shape[:-1] + (1,))
    p = jax.nn.softmax(jnp.concatenate([s_sink, s_ctx, s_loc], axis=-1), axis=-1).astype(v.dtype)
    o = (jnp.einsum('bnkgqp,bpkd->bnqkgd', p[..., 1:1 + P], cv)
         + jnp.einsum('bnkgqm,bnmkd->bnqkgd', p[..., 1 + P:], vband))
    return o.reshape(Bn, L, KV * G * D)


def _gdn_chunked(q, k, v, g, beta, s0):
    Bn, H, L, dk = q.shape
    dv = v.shape[-1]
    N = L // CHUNK
    q, k, v = [t.reshape(Bn, H, N, CHUNK, -1) for t in (q, k, v)]
    g = g.reshape(Bn, H, N, CHUNK)
    beta = beta.reshape(Bn, H, N, CHUNK)
    gc = jnp.cumsum(g, axis=-1)
    tril = jnp.tril(jnp.ones((CHUNK, CHUNK), bool))
    strict = jnp.tril(jnp.ones((CHUNK, CHUNK), bool), -1)
    diff = gc[..., :, None] - gc[..., None, :]
    decay = jnp.where(tril, jnp.exp(jnp.where(tril, diff, 0.0)), 0.0)
    kb = k * beta[..., None]
    lower = jnp.where(strict, jnp.einsum('bhncd,bhnsd->bhncs', kb, k) * decay, 0.0)
    a = lower + jnp.eye(CHUNK, dtype=F32)
    rhs = jnp.concatenate([v * beta[..., None], kb * jnp.exp(gc)[..., None]], axis=-1)
    sol = lax.linalg.triangular_solve(a, rhs, left_side=True, lower=True)
    u, w = sol[..., :dv], sol[..., dv:]
    qk = jnp.where(tril, jnp.einsum('bhncd,bhnsd->bhncs', q, k) * decay, 0.0)

    def step(S, xs):
        qi, ki, ui, wi, gi, qki = xs
        v_new = ui - jnp.einsum('bhcd,bhde->bhce', wi, S)
        o = (jnp.einsum('bhcd,bhde->bhce', qi * jnp.exp(gi)[..., None], S)
             + jnp.einsum('bhcs,bhse->bhce', qki, v_new))
        glast = gi[..., -1]
        S = (S * jnp.exp(glast)[..., None, None]
             + jnp.einsum('bhcd,bhce->bhde', ki * jnp.exp(glast[..., None] - gi)[..., None], v_new))
        return S, o

    xs = tuple(jnp.moveaxis(t, 2, 0) for t in (q, k, u, w, gc, qk))
    S, o = lax.scan(step, s0, xs)
    return jnp.moveaxis(o, 0, 2).reshape(Bn, H, L, dv), S


def _even_mixer(h, w_in, conv_w, a_log, dt_bias, norm_g, sink, w_out, ctx_state, ctx_kv):
    Bn, L, _ = h.shape
    qkv, gate, bg, qb, kvb = jnp.split(h @ w_in, EVEN_SPLITS, axis=-1)
    qkv = jax.nn.silu(_short_conv(qkv, conv_w)).astype(F32)
    qa, ka, va = [jnp.moveaxis(t.reshape(Bn, L, A_HEADS, HEAD_DIM), 2, 1) for t in jnp.split(qkv, 3, axis=-1)]
    qa = _l2norm(qa) * HEAD_DIM ** -0.5
    ka = _l2norm(ka)
    bg = bg.astype(F32).reshape(Bn, L, 2, 2, A_HEADS)
    beta = jnp.transpose(jax.nn.sigmoid(bg[:, :, 0]), (0, 2, 3, 1))
    g = -jnp.exp(a_log.astype(F32)) * jax.nn.softplus(bg[:, :, 1] + dt_bias.astype(F32))
    g = jnp.transpose(g, (0, 2, 3, 1))
    if ctx_state is None:
        s0 = jnp.zeros((Bn, 2, A_HEADS, HEAD_DIM, HEAD_DIM), F32)
    else:
        s0 = ctx_state.astype(F32)
    rev = lambda t: jnp.flip(t, axis=2)
    o_fwd, s_fwd = _gdn_chunked(qa, ka, va, g[:, 0], beta[:, 0], s0[:, 0])
    o_bwd, s_bwd = _gdn_chunked(rev(qa), rev(ka), rev(va), rev(g[:, 1]), rev(beta[:, 1]), s0[:, 1])
    o = jnp.moveaxis(o_fwd + rev(o_bwd), 1, 2)
    o = _rms(o, norm_g) * jax.nn.silu(gate.astype(F32).reshape(Bn, L, A_HEADS, HEAD_DIM))
    out_a = o.reshape(Bn, L, A_WIDTH).astype(h.dtype)
    state = jnp.stack([s_fwd, s_bwd], axis=1).astype(h.dtype)
    qb = qb.reshape(Bn, L, B_HEADS, HEAD_DIM)
    kb, vb = [t.reshape(Bn, L, B_KV_HEADS, HEAD_DIM) for t in jnp.split(kvb, 2, axis=-1)]
    kv_out = jnp.stack([kb, vb], axis=1)
    sink2 = sink.reshape(B_KV_HEADS, B_HEADS // B_KV_HEADS)
    if ctx_kv is None:
        out_b = _attn_blocked(_group(qb * HEAD_DIM ** -0.5, B_KV_HEADS), kb, vb, sink2)
    else:
        cos, sin = _axial_rope_tables(L)
        qr, kr = _rope(qb, cos, sin), _rope(kb, cos, sin)
        out_b = _banded_attn(_group(qr * HEAD_DIM ** -0.5, B_KV_HEADS), kr, vb, ctx_kv[:, 0], ctx_kv[:, 1], sink2)
    out = jnp.concatenate([out_a, out_b], axis=-1) @ w_out
    return out, state, kv_out


def _odd_mixer(h, w_in, q_g, k_g, w_out, ctx_kv):
    Bn, L, _ = h.shape
    q, k, v = jnp.split(h @ w_in, ODD_SPLITS, axis=-1)
    q = _rms(q.reshape(Bn, L, C_HEADS, HEAD_DIM), q_g)
    k = _rms(k.reshape(Bn, L, C_KV_HEADS, HEAD_DIM), k_g)
    v = v.reshape(Bn, L, C_KV_HEADS, HEAD_DIM)
    kv_out = jnp.stack([k, v], axis=1)
    if ctx_kv is not None:
        cos, sin = _axial_rope_tables(L)
        q, k = _rope(q, cos, sin), _rope(k, cos, sin)
        k = jnp.concatenate([ctx_kv[:, 0], k], axis=1)
        v = jnp.concatenate([ctx_kv[:, 1], v], axis=1)
    o = _attn_blocked(_group(q * HEAD_DIM ** -0.5, C_KV_HEADS), k, v, None)
    return o @ w_out, kv_out


def setup_inputs(seed: int = 0) -> dict:
    key = jax.random.key(seed)
    ks = jax.random.split(key, 32)
    nrm = lambda k, shape, s: jax.random.normal(k, shape, F32) * s
    dt = jnp.exp(jax.random.uniform(ks[14], (N_EVEN, 2, A_HEADS), F32, np.log(1e-3), np.log(1e-1)))
    return {
        'x_prompt': nrm(ks[0], (BATCH, SEQ, D_MODEL), 1.0),
        'x_sample': nrm(ks[1], (DEC_BATCH, DEC_SEQ, D_MODEL), 1.0),
        'state_a': nrm(ks[2], (DEC_BATCH, N_EVEN, 2, A_HEADS, HEAD_DIM, HEAD_DIM), 0.1),
        'cache_b_kv': nrm(ks[3], (DEC_BATCH, N_EVEN, 2, PAST_LEN, B_KV_HEADS, HEAD_DIM), 1.0),
        'cache_c_kv': nrm(ks[4], (DEC_BATCH, N_ODD, 2, PAST_LEN, C_KV_HEADS, HEAD_DIM), 1.0),
        'c': nrm(ks[5], (DEC_BATCH, D_MODEL), 1.0),
        'c_ctx': nrm(ks[6], (D_MODEL,), 1.0),
        'ada_w': nrm(ks[7], (DEPTH, D_MODEL, 6 * D_MODEL), 0.5 * D_MODEL ** -0.5),
        'ada_b': nrm(ks[8], (DEPTH, 6 * D_MODEL), 0.02),
        'norm1_g': 1.0 + nrm(ks[9], (DEPTH, D_MODEL), 0.02),
        'norm2_g': 1.0 + nrm(ks[10], (DEPTH, D_MODEL), 0.02),
        'final_g': 1.0 + nrm(ks[11], (D_MODEL,), 0.02),
        'mlp_w1': nrm(ks[12], (DEPTH, D_MODEL, D_FF), D_MODEL ** -0.5),
        'mlp_w2': nrm(ks[13], (DEPTH, D_FF, D_MODEL), D_FF ** -0.5),
        'ev_w_in': nrm(ks[15], (N_EVEN, D_MODEL, EVEN_IN), D_MODEL ** -0.5),
        'a_conv': nrm(ks[16], (N_EVEN, CONV_K, 3 * A_WIDTH), CONV_K ** -0.5),
        'a_log': jnp.log(jax.random.uniform(ks[17], (N_EVEN, 2, A_HEADS), F32, 1.0, 16.0)),
        'a_dt_bias': jnp.log(jnp.expm1(dt)),
        'a_norm_g': 1.0 + nrm(ks[18], (N_EVEN, HEAD_DIM), 0.02),
        'b_sink': nrm(ks[19], (N_EVEN, B_HEADS), 1.0),
        'ev_w_out': nrm(ks[20], (N_EVEN, A_WIDTH + B_WIDTH, D_MODEL), (A_WIDTH + B_WIDTH) ** -0.5),
        'od_w_in': nrm(ks[21], (N_ODD, D_MODEL, ODD_IN), D_MODEL ** -0.5),
        'c_qnorm_g': 1.0 + nrm(ks[22], (N_ODD, HEAD_DIM), 0.02),
        'c_knorm_g': 1.0 + nrm(ks[23], (N_ODD, HEAD_DIM), 0.02),
        'od_w_out': nrm(ks[24], (N_ODD, C_WIDTH, D_MODEL), C_WIDTH ** -0.5),
    }


def reference(x_prompt, x_sample, state_a, cache_b_kv, cache_c_kv, c, c_ctx, ada_w, ada_b, norm1_g, norm2_g,
              final_g, mlp_w1, mlp_w2, ev_w_in, a_conv, a_log, a_dt_bias, a_norm_g, b_sink, ev_w_out,
              od_w_in, c_qnorm_g, c_knorm_g, od_w_out):
    xp, xs = x_prompt, x_sample
    cond_p = c_ctx[None, :]
    new_a, new_b, new_c = [], [], []
    for l in range(DEPTH):
        i = l // 2
        mp = _adaln(cond_p, ada_w[l], ada_b[l])
        ms = _adaln(c, ada_w[l], ada_b[l])
        hp = _modulate(xp, norm1_g[l], mp[0], mp[1])
        hs = _modulate(xs, norm1_g[l], ms[0], ms[1])
        if l % 2 == 0:
            ev = (ev_w_in[i], a_conv[i], a_log[i], a_dt_bias[i], a_norm_g[i], b_sink[i], ev_w_out[i])
            op, sa, kvb = _even_mixer(hp, *ev, None, None)
            os_, _, _ = _even_mixer(hs, *ev, state_a[:, i], cache_b_kv[:, i])
            new_a.append(sa)
            new_b.append(kvb)
        else:
            od = (od_w_in[i], c_qnorm_g[i], c_knorm_g[i], od_w_out[i])
            op, kvc = _odd_mixer(hp, *od, None)
            os_, _ = _odd_mixer(hs, *od, cache_c_kv[:, i])
            new_c.append(kvc)
        xp = xp + mp[2] * op
        xs = xs + ms[2] * os_
        xp = xp + mp[5] * _mlp(_modulate(xp, norm2_g[l], mp[3], mp[4]), mlp_w1[l], mlp_w2[l])
        xs = xs + ms[5] * _mlp(_modulate(xs, norm2_g[l], ms[3], ms[4]), mlp_w1[l], mlp_w2[l])
    y_prompt = _rms(xp, final_g)
    y_sample = _rms(xs, final_g)
    return (y_prompt, y_sample, jnp.stack(new_a, axis=1), jnp.stack(new_b, axis=1), jnp.stack(new_c, axis=1))
```

```cpp
#include <hip/hip_runtime.h>
#include <hip/hip_cooperative_groups.h>
#include <cstdio>
#include <cstdint>
namespace cg = cooperative_groups;

#define LAS __attribute__((address_space(3)))
typedef unsigned short bf16_t;
typedef short bf16x8 __attribute__((ext_vector_type(8)));
typedef short s16x4 __attribute__((ext_vector_type(4)));
typedef float f32x4 __attribute__((ext_vector_type(4)));
typedef float f32x2 __attribute__((ext_vector_type(2)));
typedef float f32x16 __attribute__((ext_vector_type(16)));
typedef unsigned u32x4 __attribute__((ext_vector_type(4)));
typedef unsigned u32x2 __attribute__((ext_vector_type(2)));

constexpr int DM = 1024, NTOK = 12288, NPR = 4096, DFF = 4096;
constexpr int EVN = 3328, EVLD = 3072, ODN = 1536;
constexpr float EPS = 1e-6f;
constexpr float SCALE = 0.088388347648318440f;

constexpr size_t MiB = 1u << 20;
constexpr size_t WS_MOD = 1 * MiB;
constexpr size_t WS_WEVIN = 2 * MiB;
constexpr size_t WS_WEVOUT = 15 * MiB;
constexpr size_t WS_WODIN = 19 * MiB;
constexpr size_t WS_WODOUT = 25 * MiB;
constexpr size_t WS_W1 = 29 * MiB;
constexpr size_t WS_W2 = 61 * MiB;
constexpr size_t WS_CTXB = 93 * MiB;
constexpr size_t WS_CTXC = 97 * MiB;
constexpr size_t WS_H = 101 * MiB;
constexpr size_t WS_MIX = 125 * MiB;
constexpr size_t WS_BG = 149 * MiB;
constexpr size_t WS_BETA = 150 * MiB;
constexpr size_t WS_G = 150 * MiB + 512 * 1024;
constexpr size_t WS_GC = 151 * MiB;
constexpr size_t WS_D = 152 * MiB;
constexpr size_t WS_QN = 224 * MiB;
constexpr size_t WS_KN = 236 * MiB;
constexpr size_t WS_VN = 248 * MiB;
constexpr size_t WS_KNT = 260 * MiB;
constexpr size_t WS_U = 272 * MiB;
constexpr size_t WS_W = 296 * MiB;
constexpr size_t WS_QK = 320 * MiB;
constexpr size_t WS_ODN = 332 * MiB;
constexpr size_t WS_END = 380 * MiB;

constexpr size_t OUT_STATE = 12582912, OUT_CB = 16777216, OUT_CC = 20971520;

constexpr int LDS_BYTES = 147456;
#ifndef NLAYERS
#define NLAYERS 4
#endif
#ifndef STOP_PH
#define STOP_PH 99
#endif

__device__ __forceinline__ unsigned cvt_pk(float lo, float hi) { unsigned r; asm volatile("v_cvt_pk_bf16_f32 %0, %1, %2" : "=v"(r) : "v"(lo), "v"(hi)); return r; }
__device__ __forceinline__ unsigned f2bf(float f) { return cvt_pk(f, 0.f) & 0xffffu; }
__device__ __forceinline__ float bf2f(unsigned h) { return __uint_as_float(h << 16); }
__device__ __forceinline__ float bflo(unsigned w) { return __uint_as_float(w << 16); }
__device__ __forceinline__ float bfhi(unsigned w) { return __uint_as_float(w & 0xffff0000u); }
__device__ __forceinline__ float wave_sum(float v) {
#pragma unroll
    for (int o = 1; o < 64; o <<= 1) v += __shfl_xor(v, o);
    return v;
}
__device__ __forceinline__ float silu_f(float x) { return x / (1.f + __expf(-x)); }
#define LDS_WAIT() asm volatile("s_waitcnt lgkmcnt(0)" ::: "memory")

namespace pg8 {
#define PG8_LAS __attribute__((address_space(3)))
constexpr int BM = 256, BK = 64, HALF = 128, HTB = HALF * BK * 2, STAGE_BYTES = 8 * HTB, NXCD = 8, WGM = 8;
__host__ __device__ __forceinline__ int lds_byte(int r, int c) { const int st = (r >> 4) * 2 + (c >> 5), rr = r & 15, cc = c & 31, ob = rr * 64 + cc * 2; return st * 1024 + (ob ^ (((ob >> 9) & 1) << 5)); }
__host__ __device__ __forceinline__ void stage_rc(int b, int& R, int& C) { const int st = b / 1024, sb = b % 1024, swz = sb ^ (((sb >> 9) & 1) << 5); R = (st >> 1) * 16 + swz / 64; C = (st & 1) * 32 + (swz % 64) / 2; }
__host__ __device__ __forceinline__ int perm32(int rho) { const int n = rho >> 4, i = rho & 15; return 8 * (i >> 2) + 4 * n + (i & 3); }
struct Unit { int pm, pn; };
struct Gemm { const bf16_t* A; const bf16_t* Bt; int M, N, K; };
struct StaticOrder {
    int nM, nN, nwg, G, c;
    __device__ void init(int M, int N, int G_, int c_) { nM = M / BM; nN = N / BM; nwg = nM * nN; G = G_; c = c_; }
    __device__ bool next(int i, Unit& u) const {
        const long L = (long)i * G + c; if (L >= nwg) return false;
        int wgid = (int)L; { const int q = nwg / NXCD, r = nwg % NXCD, xcd = wgid % NXCD, off = wgid / NXCD; wgid = (xcd < r ? xcd * (q + 1) : r * (q + 1) + (xcd - r) * q) + off; }
        const int nig = WGM * nN, gid = wgid / nig, fm = gid * WGM, gsz = (nM - fm) < WGM ? (nM - fm) : WGM;
        u.pm = fm + ((wgid % nig) % gsz); u.pn = (wgid % nig) / gsz; return true;
    }
};

struct EpiProj {
    static constexpr bool PERM = true;
    bf16_t* O; int ldc; int npn_store; float* cache; int pn_k, pn_lo, pn_hi; float* bg; int pn_bg;
    __device__ __forceinline__ void operator()(const f32x4 (&acc)[2][2][4][2], const Unit& u, int wr, int wc, int fr, int fq) const {
        const int row0 = u.pm * BM + wr * 64 + fr, colt = u.pn * BM + wc * 32 + 8 * fq;
        const bool st = u.pn < npn_store;
        const bool cf = (u.pm < 16) && (u.pn >= pn_lo) && (u.pn < pn_hi);
        const bool bgf = (u.pn == pn_bg) && (wc == 0) && (fq < 2);
        float* cb = cache + (size_t)(u.pm * 4 + (u.pn - pn_k)) * 65536;
#pragma unroll
        for (int ai = 0; ai < 2; ++ai)
#pragma unroll
            for (int m = 0; m < 4; ++m) {
                const int r = row0 + ai * HALF + m * 16, rt = wr * 64 + fr + ai * HALF + m * 16;
#pragma unroll
                for (int bj = 0; bj < 2; ++bj) {
                    const f32x4 v0 = acc[ai][bj][m][0], v1 = acc[ai][bj][m][1];
                    if (st) { u32x4 w; w.x = cvt_pk(v0[0], v0[1]); w.y = cvt_pk(v0[2], v0[3]); w.z = cvt_pk(v1[0], v1[1]); w.w = cvt_pk(v1[2], v1[3]);
                        *(u32x4*)(O + (size_t)r * ldc + colt + bj * HALF) = w; }
                    if (cf) { float* d = cb + rt * 256 + wc * 32 + 8 * fq + bj * HALF; *(f32x4*)d = v0; *(f32x4*)(d + 4) = v1; }
                    if (bgf && bj == 0) { float* d = bg + (size_t)r * 16 + 8 * fq; *(f32x4*)d = v0; *(f32x4*)(d + 4) = v1; }
                }
            }
    }
};
struct EpiAct {
    static constexpr bool PERM = true;
    bf16_t* O; int ldc;
    __device__ __forceinline__ void operator()(const f32x4 (&acc)[2][2][4][2], const Unit& u, int wr, int wc, int fr, int fq) const {
        const int row0 = u.pm * BM + wr * 64 + fr, colt = u.pn * BM + wc * 32 + 8 * fq;
#pragma unroll
        for (int ai = 0; ai < 2; ++ai)
#pragma unroll
            for (int m = 0; m < 4; ++m) {
                bf16_t* rowp = O + (size_t)(row0 + ai * HALF + m * 16) * ldc + colt;
#pragma unroll
                for (int bj = 0; bj < 2; ++bj) {
                    f32x4 v0 = acc[ai][bj][m][0], v1 = acc[ai][bj][m][1];
#pragma unroll
                    for (int j = 0; j < 4; ++j) { float a = fmaxf(v0[j], 0.f); v0[j] = a * a; float b = fmaxf(v1[j], 0.f); v1[j] = b * b; }
                    u32x4 w; w.x = cvt_pk(v0[0], v0[1]); w.y = cvt_pk(v0[2], v0[3]); w.z = cvt_pk(v1[0], v1[1]); w.w = cvt_pk(v1[2], v1[3]);
                    *(u32x4*)(rowp + bj * HALF) = w;
                }
            }
    }
};
struct EpiResid {
    static constexpr bool PERM = false;
    float* X; const float* gate; const float* xin_p; const float* xin_s;
    __device__ __forceinline__ void operator()(const f32x4 (&acc)[2][2][4][2], const Unit& u, int wr, int wc, int fr, int fq) const {
        const int row0 = u.pm * BM + wr * 64 + fr, col0 = u.pn * BM + wc * 32 + 4 * fq;
        const int cidx = u.pm < 16 ? 0 : 1 + ((u.pm - 16) >> 3);
        const float* srcb = xin_p ? (u.pm < 16 ? xin_p : xin_s - (size_t)NPR * DM) : X;
        const float* gp = gate + cidx * 6144 + col0;
        f32x4 gv[2][2];
#pragma unroll
        for (int bj = 0; bj < 2; ++bj)
#pragma unroll
            for (int n = 0; n < 2; ++n) gv[bj][n] = *(const f32x4*)(gp + bj * HALF + n * 16);
#pragma unroll
        for (int ai = 0; ai < 2; ++ai)
#pragma unroll
            for (int m = 0; m < 4; ++m) {
                float* rowp = X + (size_t)(row0 + ai * HALF + m * 16) * DM + col0;
                const float* rows = srcb + (size_t)(row0 + ai * HALF + m * 16) * DM + col0;
#pragma unroll
                for (int bj = 0; bj < 2; ++bj)
#pragma unroll
                    for (int n = 0; n < 2; ++n) { f32x4 x = *(const f32x4*)(rows + bj * HALF + n * 16); x = x + gv[bj][n] * acc[ai][bj][m][n]; *(f32x4*)(rowp + bj * HALF + n * 16) = x; }
            }
    }
};

template <class Epi>
__device__ __forceinline__ void gemm_phase(PG8_LAS unsigned char* lds, const Gemm g, const StaticOrder& S, const Epi& E) {
    int tid = threadIdx.x; asm volatile("" : "+v"(tid));
    const int wid = __builtin_amdgcn_readfirstlane(tid >> 6), lane = tid & 63, wr = wid >> 2, wc = wid & 3, fr = lane & 15, fq = lane >> 4;
    const int K = g.K, nt = K / BK;
    unsigned voffA[2], voffB[2];
#pragma unroll
    for (int i = 0; i < 2; ++i) { int R, C; stage_rc(tid * 16 + i * 8192, R, C); const int Rb = Epi::PERM ? ((R & ~31) + perm32(R & 31)) : R;
        voffA[i] = (unsigned)(R * K + C) * 2u; voffB[i] = (unsigned)(Rb * K + C) * 2u; }
    const size_t kstep = (size_t)(BK * 2);
    const size_t hstep = (size_t)HALF * K * 2;
    const size_t tstep = 2 * hstep;
    const unsigned ldsw = (unsigned)wid * 1024u;
    const int aoff = lds_byte(wr * 64 + fr, fq * 8), boff = lds_byte(wc * 32 + fr, fq * 8);
#define PG8_SA(b, h) (((b) * 2 + (h)) * HTB)
#define PG8_SB(b, h) ((4 + (b) * 2 + (h)) * HTB)
#define PG8_STAGE(bufoff, gbase, voff) do { _Pragma("unroll") for (int _i = 0; _i < 2; ++_i) \
        __builtin_amdgcn_global_load_lds((const unsigned*)((const char*)(gbase) + (voff)[_i]), (PG8_LAS unsigned*)(lds + (bufoff) + ldsw + _i * 8192), 16, 0, 0); } while (0)
#define PG8_LDA(dst, b, h) do { _Pragma("unroll") for (int m = 0; m < 4; ++m) _Pragma("unroll") for (int k = 0; k < 2; ++k) dst[m][k] = *(const PG8_LAS bf16x8*)(lds + PG8_SA(b, h) + aoff + m * 2048 + k * 1024); } while (0)
#define PG8_LDB(dst, b, h) do { _Pragma("unroll") for (int n = 0; n < 2; ++n) _Pragma("unroll") for (int k = 0; k < 2; ++k) dst[n][k] = *(const PG8_LAS bf16x8*)(lds + PG8_SB(b, h) + boff + n * 2048 + k * 1024); } while (0)
#define PG8_MMA(ai, bj, At, Bt) do { __builtin_amdgcn_s_setprio(1); _Pragma("unroll") for (int m = 0; m < 4; ++m) _Pragma("unroll") for (int n = 0; n < 2; ++n) _Pragma("unroll") for (int k = 0; k < 2; ++k) \
        acc[ai][bj][m][n] = __builtin_amdgcn_mfma_f32_16x16x32_bf16(Bt[n][k], At[m][k], acc[ai][bj][m][n], 0, 0, 0); __builtin_amdgcn_s_setprio(0); } while (0)
#define PG8_WAIT_V(n) asm volatile("s_waitcnt vmcnt(" #n ")" ::: "memory")
#define PG8_WAIT_L(n) asm volatile("s_waitcnt lgkmcnt(" #n ")" ::: "memory")
#define PG8_BAR __builtin_amdgcn_s_barrier()
#define PG8_SCHED __builtin_amdgcn_sched_barrier(0)
    Unit cur, nxt; int ui = 0;
    if (!S.next(0, cur)) return;
    f32x4 acc[2][2][4][2];
#pragma unroll
    for (int a = 0; a < 2; ++a)
#pragma unroll
        for (int b = 0; b < 2; ++b)
#pragma unroll
            for (int m = 0; m < 4; ++m)
#pragma unroll
                for (int n = 0; n < 2; ++n) acc[a][b][m][n] = (f32x4){0.f, 0.f, 0.f, 0.f};
    bf16x8 At[4][2], B0[2][2], B1[2][2];
    const char* cA = (const char*)g.A + (size_t)cur.pm * tstep; const char* cB = (const char*)g.Bt + (size_t)cur.pn * tstep;
    PG8_STAGE(PG8_SB(0, 0), cB, voffB); PG8_STAGE(PG8_SA(0, 0), cA, voffA); PG8_STAGE(PG8_SB(0, 1), cB + hstep, voffB); PG8_STAGE(PG8_SA(0, 1), cA + hstep, voffA);
    if (wr == 1) PG8_BAR;
    PG8_WAIT_V(4); PG8_BAR;
    PG8_STAGE(PG8_SB(1, 0), cB + kstep, voffB); PG8_STAGE(PG8_SA(1, 0), cA + kstep, voffA); PG8_STAGE(PG8_SB(1, 1), cB + hstep + kstep, voffB);
    PG8_WAIT_V(6); PG8_BAR;
    for (;;) {
        const bool has_next = S.next(ui + 1, nxt);
        const char* nA = has_next ? (const char*)g.A + (size_t)nxt.pm * tstep : cA; const char* nB = has_next ? (const char*)g.Bt + (size_t)nxt.pn * tstep : cB;
        for (int t = 0; t < nt; t += 2) {
            const bool last = (t == nt - 2);
            const char* a1 = cA + (size_t)(t + 1) * kstep;
            const char* a2 = last ? nA : cA + (size_t)(t + 2) * kstep; const char* b2 = last ? nB : cB + (size_t)(t + 2) * kstep;
            const char* a3 = a2 + kstep; const char* b3 = b2 + kstep;
            PG8_LDB(B0, 0, 0); PG8_SCHED; PG8_LDA(At, 0, 0); PG8_STAGE(PG8_SA(1, 1), a1 + hstep, voffA);
            PG8_WAIT_L(8); PG8_BAR; PG8_WAIT_L(0); PG8_MMA(0, 0, At, B0); PG8_BAR; PG8_SCHED;
            PG8_LDB(B1, 0, 1); PG8_STAGE(PG8_SB(0, 0), b2, voffB);
            PG8_BAR; PG8_WAIT_L(0); PG8_MMA(0, 1, At, B1); PG8_BAR;
            PG8_LDA(At, 0, 1); PG8_STAGE(PG8_SA(0, 0), a2, voffA);
            PG8_BAR; PG8_WAIT_L(0); PG8_MMA(1, 0, At, B0); PG8_BAR; PG8_SCHED;
            PG8_STAGE(PG8_SB(0, 1), b2 + hstep, voffB);
            PG8_WAIT_V(6); PG8_BAR; PG8_MMA(1, 1, At, B1); PG8_BAR;
            PG8_LDB(B0, 1, 0); PG8_SCHED; PG8_LDA(At, 1, 0); PG8_STAGE(PG8_SA(0, 1), a2 + hstep, voffA);
            PG8_WAIT_L(8); PG8_BAR; PG8_WAIT_L(0); PG8_MMA(0, 0, At, B0); PG8_BAR; PG8_SCHED;
            PG8_LDB(B1, 1, 1); PG8_STAGE(PG8_SB(1, 0), b3, voffB);
            PG8_BAR; PG8_WAIT_L(0); PG8_MMA(0, 1, At, B1); PG8_BAR;
            PG8_LDA(At, 1, 1); PG8_STAGE(PG8_SA(1, 0), a3, voffA);
            PG8_BAR; PG8_WAIT_L(0); PG8_MMA(1, 0, At, B0); PG8_BAR; PG8_SCHED;
            PG8_STAGE(PG8_SB(1, 1), b3 + hstep, voffB);
            PG8_WAIT_V(6); PG8_BAR; PG8_MMA(1, 1, At, B1); PG8_BAR;
        }
        E(acc, cur, wr, wc, fr, fq);
        if (!has_next) break;
#pragma unroll
        for (int a = 0; a < 2; ++a)
#pragma unroll
            for (int b = 0; b < 2; ++b)
#pragma unroll
                for (int m = 0; m < 4; ++m)
#pragma unroll
                    for (int n = 0; n < 2; ++n) acc[a][b][m][n] = (f32x4){0.f, 0.f, 0.f, 0.f};
        cur = nxt; cA = nA; cB = nB; ++ui;
    }
    PG8_WAIT_V(0);
    if (wr == 0) PG8_BAR;
    PG8_BAR;
#undef PG8_SA
#undef PG8_SB
#undef PG8_STAGE
#undef PG8_LDA
#undef PG8_LDB
#undef PG8_MMA
#undef PG8_WAIT_V
#undef PG8_WAIT_L
#undef PG8_BAR
#undef PG8_SCHED
}
}

namespace att {
constexpr int D = 128, NW = 8, QBLK = 32, KVBLK = 64;
constexpr float THR = 8.f;
#ifndef ATT_SDEPTH
#define ATT_SDEPTH 1
#endif
constexpr size_t SHM_V = KVBLK * D * 2, SHM_K = KVBLK * D * 2, SHM_ATTN = 2 * SHM_V + 2 * SHM_K + NW * 64 * 4;
#define KSWZ(row, colB) ((row) * 256 + ((colB) ^ (((row) & 7) << 4)))
#define SBAR() __builtin_amdgcn_sched_barrier(0)
__device__ __forceinline__ int crow(int r, int hi) { return (r & 3) + 8 * (r >> 2) + 4 * hi; }
__device__ __forceinline__ void partialSM(f32x16& p0, f32x16& p1, float& m_reg, float& mn, float& alpha) {
    constexpr float C = SCALE * 1.4426950408889634f;
    float pmax = p0[0];
#pragma unroll
    for (int r = 1; r < 16; ++r) pmax = fmaxf(pmax, p0[r]);
#pragma unroll
    for (int r = 0; r < 16; ++r) pmax = fmaxf(pmax, p1[r]);
    { auto rr = __builtin_amdgcn_permlane32_swap(__float_as_uint(pmax), __float_as_uint(pmax), false, false);
      pmax = fmaxf(__uint_as_float(rr[0]), __uint_as_float(rr[1])); }
    if (__builtin_expect(__all(pmax - m_reg <= THR / SCALE), 1)) { mn = m_reg; alpha = 1.f; }
    else { mn = fmaxf(m_reg, pmax); alpha = __builtin_amdgcn_exp2f((m_reg - mn) * C); m_reg = mn; }
    float mnC = -mn * C;
#pragma unroll
    for (int r = 0; r < 16; ++r) p0[r] = fmaf(p0[r], C, mnC);
#pragma unroll
    for (int r = 0; r < 16; ++r) p1[r] = fmaf(p1[r], C, mnC);
#pragma unroll
    for (int r = 0; r < 16; ++r) p0[r] = __builtin_amdgcn_exp2f(p0[r]);
}
__device__ __forceinline__ void finishSM(f32x16& p0, f32x16& p1, float alpha, float& l_reg, bf16x8& pa0, bf16x8& pa1, bf16x8& pa2, bf16x8& pa3) {
#pragma unroll
    for (int r = 0; r < 16; ++r) p1[r] = __builtin_amdgcn_exp2f(p1[r]);
    float ps = 0;
#pragma unroll
    for (int r = 0; r < 16; ++r) ps += p0[r];
#pragma unroll
    for (int r = 0; r < 16; ++r) ps += p1[r];
    { auto rr = __builtin_amdgcn_permlane32_swap(__float_as_uint(ps), __float_as_uint(ps), false, false);
      ps = __uint_as_float(rr[0]) + __uint_as_float(rr[1]); }
    l_reg = l_reg * alpha + ps;
#define PK4(P, BASE, OUT) do { unsigned a0 = cvt_pk(P[BASE + 0], P[BASE + 1]), a1 = cvt_pk(P[BASE + 2], P[BASE + 3]);   \
    unsigned b0 = cvt_pk(P[BASE + 4], P[BASE + 5]), b1 = cvt_pk(P[BASE + 6], P[BASE + 7]);                              \
    auto r0 = __builtin_amdgcn_permlane32_swap(a0, b0, false, false); auto r1 = __builtin_amdgcn_permlane32_swap(a1, b1, false, false); \
    u32x4 w = {r0[0], r1[0], r0[1], r1[1]}; OUT = *reinterpret_cast<bf16x8*>(&w); } while (0)
    PK4(p0, 0, pa0); PK4(p0, 8, pa1); PK4(p1, 0, pa2); PK4(p1, 8, pa3);
#undef PK4
}
__device__ __forceinline__ void qkt(f32x16& p0, f32x16& p1, const bf16_t* Ks, const bf16x8* qr, int r32, int hi) {
    p0 = f32x16{}; p1 = f32x16{};
#pragma unroll
    for (int d0 = 0; d0 < 8; ++d0) { int cb = (d0 * 16 + hi * 8) * 2;
        bf16x8 b0 = *reinterpret_cast<const bf16x8*>((const char*)Ks + KSWZ(r32, cb));
        bf16x8 b1 = *reinterpret_cast<const bf16x8*>((const char*)Ks + KSWZ(32 + r32, cb));
        p0 = __builtin_amdgcn_mfma_f32_32x32x16_bf16(b0, qr[d0], p0, 0, 0, 0);
        p1 = __builtin_amdgcn_mfma_f32_32x32x16_bf16(b1, qr[d0], p1, 0, 0, 0); }
}
template <bool BAND> __device__ __forceinline__ void maskp(f32x16& p0, f32x16& p1, int t, int nct, int qp, int hi) {
    if constexpr (BAND) {
        if (t >= nct) {
            const int kb = (t - nct) * 64;
#pragma unroll
            for (int r = 0; r < 16; ++r) { const int kp = kb + crow(r, hi); int dd = qp - kp; dd = dd < 0 ? -dd : dd; if (dd > 128) p0[r] = -1e30f;
                int d2 = qp - kp - 32; d2 = d2 < 0 ? -d2 : d2; if (d2 > 128) p1[r] = -1e30f; }
        }
    }
}
__device__ __forceinline__ int v_st(int k, int c) { const int kk = (k & ~0xC) | ((k & 4) << 1) | ((k & 8) >> 1); return ((kk >> 3) * 4 + (c >> 5)) * 512 + ((kk & 7) * 32 + (c & 31)) * 2; }
__device__ __forceinline__ int v_rd_base(int lane) { return ((lane & 3) << 3) | (((lane >> 2) & 3) << 6) | (((lane >> 4) & 1) << 5) | (((lane >> 5) & 1) << 8); }
constexpr int v_rd_off(int d0, int ks, int half) { return d0 * 512 + ks * 4096 + half * 2048; }
template <int OFF> __device__ __forceinline__ s16x4 tr_read(int vb) {
    s16x4 r; asm volatile("ds_read_b64_tr_b16 %0, %1 offset:%2" : "=&v"(r) : "v"(vb), "i"(OFF) : "memory"); return r;
}
template <int D0> __device__ __forceinline__ void pv_one(f32x16& od, int vb, bf16x8 pa0, bf16x8 pa1, bf16x8 pa2, bf16x8 pa3) {
    const s16x4 l0 = tr_read<v_rd_off(D0, 0, 0)>(vb), h0 = tr_read<v_rd_off(D0, 0, 1)>(vb), l1 = tr_read<v_rd_off(D0, 1, 0)>(vb), h1 = tr_read<v_rd_off(D0, 1, 1)>(vb);
    const s16x4 l2 = tr_read<v_rd_off(D0, 2, 0)>(vb), h2 = tr_read<v_rd_off(D0, 2, 1)>(vb), l3 = tr_read<v_rd_off(D0, 3, 0)>(vb), h3 = tr_read<v_rd_off(D0, 3, 1)>(vb);
    asm volatile("s_waitcnt lgkmcnt(0)" ::: "memory"); SBAR();
#define PK(L, H) (bf16x8){L[0], L[1], L[2], L[3], H[0], H[1], H[2], H[3]}
    od = __builtin_amdgcn_mfma_f32_32x32x16_bf16(pa0, PK(l0, h0), od, 0, 0, 0);
    od = __builtin_amdgcn_mfma_f32_32x32x16_bf16(pa1, PK(l1, h1), od, 0, 0, 0);
    od = __builtin_amdgcn_mfma_f32_32x32x16_bf16(pa2, PK(l2, h2), od, 0, 0, 0);
    od = __builtin_amdgcn_mfma_f32_32x32x16_bf16(pa3, PK(l3, h3), od, 0, 0, 0);
#undef PK
}
__device__ __forceinline__ void pv_d0(f32x16* o, int vb, bf16x8 pa0, bf16x8 pa1, bf16x8 pa2, bf16x8 pa3) {
    pv_one<0>(o[0], vb, pa0, pa1, pa2, pa3); pv_one<1>(o[1], vb, pa0, pa1, pa2, pa3); pv_one<2>(o[2], vb, pa0, pa1, pa2, pa3); pv_one<3>(o[3], vb, pa0, pa1, pa2, pa3);
}

template <bool BAND>
__device__ __forceinline__ void attn_body(const bf16_t* __restrict__ Qb, int ldq, const bf16_t* __restrict__ Kc, const bf16_t* __restrict__ Vc, int ldc, int nct,
                                          const bf16_t* __restrict__ Kl, const bf16_t* __restrict__ Vl, int ldl, int NT,
                                          bf16_t* __restrict__ Ob, int ldo, float m_init, float l_init, int qoff, char* lds) {
    int tid = threadIdx.x; asm volatile("" : "+v"(tid));
    const int wid = tid >> 6, lane = tid & 63, r32 = lane & 31, hi = lane >> 5;
    bf16_t* V_lds = (bf16_t*)lds; bf16_t* K_lds = (bf16_t*)(lds + 2 * SHM_V);
    float* wsl = (float*)(lds + 2 * SHM_V + 2 * SHM_K) + wid * 64; float* li_l = wsl; float* al_l = wsl + 32;
    float m_reg = m_init, l_reg = l_init; f32x16 o[4] = {}; bf16x8 qr[8];
    const bf16_t* Qw = Qb + (long)(wid * QBLK + r32) * ldq + hi * 8;
#pragma unroll
    for (int d0 = 0; d0 < 8; ++d0) qr[d0] = *reinterpret_cast<const bf16x8*>(Qw + d0 * 16);
    const int sr = tid >> 4, sc = (tid & 15) * 8, vst0 = v_st(sr, sc), vst1 = v_st(32 + sr, sc);
    const int vb0 = (int)(uintptr_t)V_lds + v_rd_base(lane);
    const int qp = qoff + wid * QBLK + r32;
    const int offc = sr * ldc + sc, offl = sr * ldl + sc;
    constexpr int SDEPTH = ATT_SDEPTH;
    struct { bf16x8 vs0, vs1, ks0, ks1; } sr_[SDEPTH];
#define SLOAD(i, t) do { const bool _c = (t) < nct; const bf16_t* _k = _c ? Kc + (long)(t) * 64 * ldc : Kl + (long)((t) - nct) * 64 * ldl; \
    const bf16_t* _v = _c ? Vc + (long)(t) * 64 * ldc : Vl + (long)((t) - nct) * 64 * ldl; const int _o = _c ? offc : offl; const int _h = (_c ? ldc : ldl) * 32; \
    sr_[i].vs0 = *reinterpret_cast<const bf16x8*>(_v + _o); sr_[i].vs1 = *reinterpret_cast<const bf16x8*>(_v + _o + _h); \
    sr_[i].ks0 = *reinterpret_cast<const bf16x8*>(_k + _o); sr_[i].ks1 = *reinterpret_cast<const bf16x8*>(_k + _o + _h); } while (0)
#define SWRITE(b, i) do { *(bf16x8*)((char*)V_lds + (b) * SHM_V + vst0) = sr_[i].vs0;          \
    *(bf16x8*)((char*)V_lds + (b) * SHM_V + vst1) = sr_[i].vs1; int kc = sc * 2;               \
    *(bf16x8*)((char*)K_lds + (b) * SHM_K + KSWZ(sr, kc)) = sr_[i].ks0;                       \
    *(bf16x8*)((char*)K_lds + (b) * SHM_K + KSWZ(32 + sr, kc)) = sr_[i].ks1; } while (0)
#define SWAIT() do { if constexpr (SDEPTH == 2) asm volatile("s_waitcnt vmcnt(4)" ::: "memory"); else asm volatile("s_waitcnt vmcnt(0)" ::: "memory"); } while (0)
#define RESC(a) do { if (__any((a) < 1.f)) { if (hi == 0) al_l[r32] = (a); asm volatile("s_waitcnt lgkmcnt(0)" ::: "memory"); \
    _Pragma("unroll") for (int d = 0; d < 4; ++d) _Pragma("unroll") for (int r = 0; r < 16; ++r) o[d][r] *= al_l[crow(r, hi)]; } } while (0)
    f32x16 pA0, pA1, pB0, pB1; float mnA, mnB, alA, alB; bf16x8 pa0, pa1, pa2, pa3;
    constexpr int SE = 0, SO = SDEPTH - 1;
    SLOAD(SE, 0); asm volatile("s_waitcnt vmcnt(0)" ::: "memory"); SWRITE(0, SE); __syncthreads();
    qkt(pA0, pA1, K_lds, qr, r32, hi); maskp<BAND>(pA0, pA1, 0, nct, qp, hi); partialSM(pA0, pA1, m_reg, mnA, alA);
    SLOAD(SO, 1); if constexpr (SDEPTH == 2) { if (2 < NT) SLOAD(SE, 2); }
    SWAIT(); SWRITE(1, SO); __syncthreads();
    for (int j = 1; j + 1 < NT; j += 2) {
        SBAR(); qkt(pB0, pB1, (bf16_t*)((char*)K_lds + SHM_K), qr, r32, hi); maskp<BAND>(pB0, pB1, j, nct, qp, hi);
        finishSM(pA0, pA1, alA, l_reg, pa0, pa1, pa2, pa3); SBAR();
        SLOAD(SO, j + SDEPTH); SBAR();
        pv_d0(o, vb0, pa0, pa1, pa2, pa3); partialSM(pB0, pB1, m_reg, mnB, alB);
        __syncthreads(); SWAIT(); SWRITE(0, SE);
        RESC(alB); __syncthreads();
        SBAR(); qkt(pA0, pA1, K_lds, qr, r32, hi); maskp<BAND>(pA0, pA1, j + 1, nct, qp, hi);
        finishSM(pB0, pB1, alB, l_reg, pa0, pa1, pa2, pa3); SBAR();
        if (SDEPTH == 1 || j + 3 < NT) SLOAD(SE, j + 1 + SDEPTH); SBAR();
        pv_d0(o, vb0 + (int)SHM_V, pa0, pa1, pa2, pa3); partialSM(pA0, pA1, m_reg, mnA, alA);
        __syncthreads(); SWAIT(); SWRITE(1, SO);
        RESC(alA); __syncthreads();
    }
    SBAR(); qkt(pB0, pB1, (bf16_t*)((char*)K_lds + SHM_K), qr, r32, hi); maskp<BAND>(pB0, pB1, NT - 1, nct, qp, hi);
    finishSM(pA0, pA1, alA, l_reg, pa0, pa1, pa2, pa3); SBAR();
    pv_d0(o, vb0, pa0, pa1, pa2, pa3); partialSM(pB0, pB1, m_reg, mnB, alB);
    __syncthreads(); RESC(alB);
    finishSM(pB0, pB1, alB, l_reg, pa0, pa1, pa2, pa3); SBAR();
    pv_d0(o, vb0 + (int)SHM_V, pa0, pa1, pa2, pa3);
    if (hi == 0) li_l[r32] = l_reg; asm volatile("s_waitcnt lgkmcnt(0)" ::: "memory");
    float rli[16];
#pragma unroll
    for (int r = 0; r < 16; ++r) rli[r] = __builtin_amdgcn_rcpf(li_l[crow(r, hi)]);
    bf16_t* Ow = Ob + (long)(wid * QBLK) * ldo;
#pragma unroll
    for (int r = 0; r < 16; ++r) { int orow = crow(r, hi);
#pragma unroll
        for (int d0 = 0; d0 < 4; ++d0) Ow[(long)orow * ldo + d0 * 32 + r32] = (bf16_t)f2bf(o[d0][r] * rli[r]); }
    __syncthreads();
#undef SLOAD
#undef SWRITE
#undef SWAIT
#undef RESC
}
}

struct Params {
    const float *x_prompt, *x_sample, *state_a, *cache_b, *cache_c, *c, *c_ctx, *ada_w, *ada_b, *norm1_g, *norm2_g, *final_g,
                *mlp_w1, *mlp_w2, *ev_w_in, *a_conv, *a_log, *a_dt_bias, *a_norm_g, *b_sink, *ev_w_out, *od_w_in, *c_qnorm_g, *c_knorm_g, *od_w_out;
    float* out; unsigned char* ws;
};

template <int MAP>
__device__ __forceinline__ void transpose_item(const float* W, int K, int Nsrc, bf16_t* WT, int nblk, LAS float* scr, int item, int lane) {
    const int kb = item / nblk, nb = item % nblk, k0 = 64 * kb, n0 = 32 * nb;
    const int nd = n0 + (lane & 31);
    int src = nd;
    if (MAP == 1) src = nd < 2048 ? nd : (nd < 3072 ? nd + 16 : (nd < 3088 ? nd - 1024 : -1));
    float tv[32];
#pragma unroll
    for (int i = 0; i < 32; ++i) { const int kk = 2 * i + (lane >> 5); const float wv_ = W[(size_t)(k0 + kk) * Nsrc + (src >= 0 ? src : 0)]; tv[i] = src >= 0 ? wv_ : 0.f; }
#pragma unroll
    for (int i = 0; i < 32; ++i) { const int kk = 2 * i + (lane >> 5); scr[kk * 33 + (lane & 31)] = tv[i]; }
    LDS_WAIT();
    const int c = lane & 7;
#pragma unroll
    for (int j = 0; j < 4; ++j) { const int n = (lane >> 3) + 8 * j; const LAS float* s = scr + (8 * c) * 33 + n;
        u32x4 o; o.x = cvt_pk(s[0 * 33], s[1 * 33]); o.y = cvt_pk(s[2 * 33], s[3 * 33]); o.z = cvt_pk(s[4 * 33], s[5 * 33]); o.w = cvt_pk(s[6 * 33], s[7 * 33]);
        *(u32x4*)(WT + (size_t)(n0 + n) * K + k0 + 8 * c) = o; }
    LDS_WAIT();
}


__device__ __forceinline__ void transpose_layer(const Params& p, unsigned char* ws_, int l, int gwi, int ngw, LAS float* scr, int lane) {
    asm volatile("" : "+v"(lane)); asm volatile("" : "+s"(gwi), "+s"(ngw), "+s"(l));
    const bool even = (l & 1) == 0; const int i = l >> 1;
    constexpr int I_EVIN = 16 * 104, I_SQ = 16 * 32, I_ODIN = 16 * 48, I_W1 = 16 * 128, I_W2 = 64 * 32;
    const int n_in = even ? I_EVIN : I_ODIN;
    const int nitems = n_in + I_SQ + I_W1 + I_W2;
    for (int it = gwi; it < nitems; it += ngw) {
        int r = it;
        if (r < n_in) {
            if (even) transpose_item<1>(p.ev_w_in + (size_t)i * 1024 * 3088, 1024, 3088, (bf16_t*)(ws_ + WS_WEVIN) + (size_t)i * EVN * 1024, 104, scr, r, lane);
            else transpose_item<0>(p.od_w_in + (size_t)i * 1024 * 1536, 1024, 1536, (bf16_t*)(ws_ + WS_WODIN) + (size_t)i * 1536 * 1024, 48, scr, r, lane);
            continue; }
        r -= n_in;
        if (r < I_SQ) {
            if (even) transpose_item<0>(p.ev_w_out + (size_t)i * 1024 * 1024, 1024, 1024, (bf16_t*)(ws_ + WS_WEVOUT) + (size_t)i * 1024 * 1024, 32, scr, r, lane);
            else transpose_item<0>(p.od_w_out + (size_t)i * 1024 * 1024, 1024, 1024, (bf16_t*)(ws_ + WS_WODOUT) + (size_t)i * 1024 * 1024, 32, scr, r, lane);
            continue; }
        r -= I_SQ;
        if (r < I_W1) { transpose_item<0>(p.mlp_w1 + (size_t)l * 1024 * 4096, 1024, 4096, (bf16_t*)(ws_ + WS_W1) + (size_t)l * 4096 * 1024, 128, scr, r, lane); continue; }
        r -= I_W1;
        transpose_item<0>(p.mlp_w2 + (size_t)l * 4096 * 1024, 4096, 1024, (bf16_t*)(ws_ + WS_W2) + (size_t)l * 1024 * 4096, 32, scr, r, lane);
    }
}

__device__ __forceinline__ void phase0(const Params& p, unsigned char* lds_raw, int tid, int lane, int wave, int bid, int G) {
    asm volatile("" : "+s"(bid), "+s"(G), "+s"(wave));
    size_t zo_ = 0; asm volatile("" : "+s"(zo_)); unsigned char* ws_ = p.ws + zo_;
    asm volatile("" : "+v"(tid), "+v"(lane));
    LAS unsigned char* lds = (LAS unsigned char*)lds_raw;
    LAS float* SIL = (LAS float*)(lds + 73728);
    LAS float* RED = (LAS float*)(lds + 94208);
    for (int i = tid; i < 5 * 1024; i += 512) { const int c = i >> 10, k = i & 1023; const float v = c == 0 ? p.c_ctx[k] : p.c[(c - 1) * 1024 + k]; SIL[i] = silu_f(v); }
    __syncthreads();
    float* MOD = (float*)(ws_ + WS_MOD);
    for (int it = bid; it < 768; it += G) {
        const int l = it / 192, cgp = it % 192;
        const int col = lane & 31, kh = lane >> 5;
        const float* w = p.ada_w + (size_t)l * 1024 * 6144 + cgp * 32 + col;
        float a0 = 0.f, a1 = 0.f, a2 = 0.f, a3 = 0.f, a4 = 0.f;
        const int kb = wave * 128 + kh;
#pragma unroll 32
        for (int k2 = 0; k2 < 64; ++k2) { const int k = kb + 2 * k2; const float wv = w[(size_t)k * 6144];
            a0 += SIL[k] * wv; a1 += SIL[1024 + k] * wv; a2 += SIL[2048 + k] * wv; a3 += SIL[3072 + k] * wv; a4 += SIL[4096 + k] * wv; }
        a0 += __shfl_xor(a0, 32); a1 += __shfl_xor(a1, 32); a2 += __shfl_xor(a2, 32); a3 += __shfl_xor(a3, 32); a4 += __shfl_xor(a4, 32);
        if (kh == 0) { RED[(wave * 5 + 0) * 32 + col] = a0; RED[(wave * 5 + 1) * 32 + col] = a1; RED[(wave * 5 + 2) * 32 + col] = a2; RED[(wave * 5 + 3) * 32 + col] = a3; RED[(wave * 5 + 4) * 32 + col] = a4; }
        __syncthreads();
        if (tid < 160) { const int c = tid >> 5, cc = tid & 31; float sacc = 0.f;
#pragma unroll
            for (int w8 = 0; w8 < 8; ++w8) sacc += RED[(w8 * 5 + c) * 32 + cc];
            MOD[(l * 5 + c) * 6144 + cgp * 32 + cc] = sacc + p.ada_b[l * 6144 + cgp * 32 + cc]; }
        __syncthreads();
    }
    transpose_layer(p, ws_, 0, bid * 8 + wave, G * 8, (LAS float*)(lds + wave * 9216), lane);
    const int NC8 = 262144;
    for (int i = bid * 512 + tid; i < 2 * NC8; i += G * 512) {
        const bool isb = i < NC8; const int j = isb ? i : i - NC8;
        const float* s = (isb ? p.cache_b : p.cache_c) + (size_t)j * 8;
        const f32x4 a = *(const f32x4*)s, b = *(const f32x4*)(s + 4);
        u32x4 o; o.x = cvt_pk(a[0], a[1]); o.y = cvt_pk(a[2], a[3]); o.z = cvt_pk(b[0], b[1]); o.w = cvt_pk(b[2], b[3]);
        *(u32x4*)((bf16_t*)(ws_ + (isb ? WS_CTXB : WS_CTXC)) + (size_t)j * 8) = o;
    }
}

__device__ __forceinline__ void norm_phase(const float* xp, const float* xs, float* Xcopy, const float* g, const float* modl, int shift_chunk, int scale_chunk,
                                           bf16_t* H, int gw, int NGW, int lane) {
    asm volatile("" : "+s"(gw), "+s"(NGW));
    asm volatile("" : "+v"(lane));
    for (int m = gw; m < NTOK; m += NGW) {
        const float* src = m < NPR ? xp + (size_t)m * DM : xs + (size_t)(m - NPR) * DM;
        const int cidx = m < NPR ? 0 : 1 + ((m - NPR) >> 11);
        const f32x4* xr = (const f32x4*)src + lane;
        f32x4 v[4]; float s = 0.f;
#pragma unroll
        for (int j = 0; j < 4; ++j) { v[j] = xr[64 * j]; s += (v[j].x * v[j].x + v[j].y * v[j].y) + (v[j].z * v[j].z + v[j].w * v[j].w); }
        const float rstd = rsqrtf(wave_sum(s) * (1.f / DM) + EPS);
        const f32x4* gp = (const f32x4*)g + lane;
        const f32x4* shp = (const f32x4*)(modl + cidx * 6144 + shift_chunk * 1024) + lane;
        const f32x4* scp = (const f32x4*)(modl + cidx * 6144 + scale_chunk * 1024) + lane;
        u32x2* o8 = (u32x2*)(H + (size_t)m * DM) + lane;
#pragma unroll
        for (int j = 0; j < 4; ++j) {
            const f32x4 gg = gp[64 * j], sh = shp[64 * j], sc = scp[64 * j];
            const f32x4 h = v[j] * rstd * gg * (sc + 1.f) + sh;
            u32x2 w; w.x = cvt_pk(h.x, h.y); w.y = cvt_pk(h.z, h.w); o8[64 * j] = w;
            if (Xcopy) ((f32x4*)(Xcopy + (size_t)m * DM) + lane)[64 * j] = v[j];
        }
    }
}
__device__ __forceinline__ void final_phase(float* X, const float* g, int gw, int NGW, int lane) {
    asm volatile("" : "+s"(gw), "+s"(NGW));
    asm volatile("" : "+v"(lane));
    for (int m = gw; m < NTOK; m += NGW) {
        f32x4* xr = (f32x4*)(X + (size_t)m * DM) + lane;
        f32x4 v[4]; float s = 0.f;
#pragma unroll
        for (int j = 0; j < 4; ++j) { v[j] = xr[64 * j]; s += (v[j].x * v[j].x + v[j].y * v[j].y) + (v[j].z * v[j].z + v[j].w * v[j].w); }
        const float rstd = rsqrtf(wave_sum(s) * (1.f / DM) + EPS);
        const f32x4* gp = (const f32x4*)g + lane;
#pragma unroll
        for (int j = 0; j < 4; ++j) xr[64 * j] = v[j] * rstd * gp[64 * j];
    }
}

__device__ __forceinline__ void e3a_phase(const Params& p, int i, unsigned char* lds_raw, int tid, int lane, int wave, int bid, int G) {
    asm volatile("" : "+s"(bid), "+s"(G), "+s"(wave));
    size_t zo_ = 0; asm volatile("" : "+s"(zo_)); unsigned char* ws_ = p.ws + zo_;
    asm volatile("" : "+v"(tid), "+v"(lane));
    const bf16_t* PROJ = (const bf16_t*)(ws_ + WS_D);
    bf16_t* QN = (bf16_t*)(ws_ + WS_QN); bf16_t* KN = (bf16_t*)(ws_ + WS_KN); bf16_t* VN = (bf16_t*)(ws_ + WS_VN); bf16_t* KNT = (bf16_t*)(ws_ + WS_KNT);
    const float* BG = (const float*)(ws_ + WS_BG); float* BETA = (float*)(ws_ + WS_BETA); float* GG = (float*)(ws_ + WS_G);
    LAS float* QF = (LAS float*)lds_raw;
    LAS float* KF = QF + 64 * 132;
    const float* convw = p.a_conv + (size_t)i * 3 * 1536;
    for (int it = bid; it < 768; it += G) {
        const int tb = it >> 2, h = it & 3, m0 = tb * 64;
        const bool first = tb < 64 ? ((tb & 3) == 0) : (((tb - 64) & 31) == 0);
        const bool lastb = tb < 64 ? ((tb & 3) == 3) : (((tb - 64) & 31) == 31);
        const int d = tid & 127, rg = tid >> 7, c0 = rg * 16;
#pragma unroll
        for (int part = 0; part < 3; ++part) {
            const int col = part * 512 + h * 128 + d;
            const float w0 = convw[col], w1 = convw[1536 + col], w2 = convw[3072 + col];
            const bf16_t* src = PROJ + (size_t)m0 * EVLD + col;
            const bool zp = (c0 == 0 && first);
            const float xp_ld = bf2f(src[(long)(zp ? c0 : c0 - 1) * EVLD]);
            float xprev = zp ? 0.f : xp_ld;
            float xcur = bf2f(src[(long)c0 * EVLD]);
            float vy[16];
#pragma unroll
            for (int cc = 0; cc < 16; ++cc) {
                const int c = c0 + cc;
                const bool zn = (c == 63 && lastb);
                const float xn_ld = bf2f(src[(long)(zn ? c : c + 1) * EVLD]);
                const float xnext = zn ? 0.f : xn_ld;
                const float y = silu_f(w0 * xprev + w1 * xcur + w2 * xnext);
                if (part == 0) QF[c * 132 + d] = y; else if (part == 1) KF[c * 132 + d] = y; else vy[cc] = y;
                xprev = xcur; xcur = xnext;
            }
            if (part == 2) {
                u32x4 a, b;
                a.x = cvt_pk(vy[0], vy[1]); a.y = cvt_pk(vy[2], vy[3]); a.z = cvt_pk(vy[4], vy[5]); a.w = cvt_pk(vy[6], vy[7]);
                b.x = cvt_pk(vy[8], vy[9]); b.y = cvt_pk(vy[10], vy[11]); b.z = cvt_pk(vy[12], vy[13]); b.w = cvt_pk(vy[14], vy[15]);
                bf16_t* dv = VN + ((size_t)(tb * 4 + h) * 128 + d) * 64 + c0; *(u32x4*)dv = a; *(u32x4*)(dv + 8) = b;
            }
        }
        __syncthreads();
        {
            const int row = tid >> 3, seg = tid & 7;
            LAS float* qp = QF + row * 132 + seg * 16; LAS float* kp = KF + row * 132 + seg * 16;
            float qv[16], kv[16]; float sq = 0.f, sk = 0.f;
#pragma unroll
            for (int j = 0; j < 16; ++j) { qv[j] = qp[j]; kv[j] = kp[j]; sq += qv[j] * qv[j]; sk += kv[j] * kv[j]; }
            sq += __shfl_xor(sq, 1); sq += __shfl_xor(sq, 2); sq += __shfl_xor(sq, 4);
            sk += __shfl_xor(sk, 1); sk += __shfl_xor(sk, 2); sk += __shfl_xor(sk, 4);
            const float rq = rsqrtf(sq + EPS) * SCALE, rk = rsqrtf(sk + EPS);
            u32x4 a, b;
            a.x = cvt_pk(qv[0] * rq, qv[1] * rq); a.y = cvt_pk(qv[2] * rq, qv[3] * rq); a.z = cvt_pk(qv[4] * rq, qv[5] * rq); a.w = cvt_pk(qv[6] * rq, qv[7] * rq);
            b.x = cvt_pk(qv[8] * rq, qv[9] * rq); b.y = cvt_pk(qv[10] * rq, qv[11] * rq); b.z = cvt_pk(qv[12] * rq, qv[13] * rq); b.w = cvt_pk(qv[14] * rq, qv[15] * rq);
            bf16_t* qd = QN + (size_t)(m0 + row) * 512 + h * 128 + seg * 16; *(u32x4*)qd = a; *(u32x4*)(qd + 8) = b;
#pragma unroll
            for (int j = 0; j < 16; ++j) kv[j] *= rk;
            a.x = cvt_pk(kv[0], kv[1]); a.y = cvt_pk(kv[2], kv[3]); a.z = cvt_pk(kv[4], kv[5]); a.w = cvt_pk(kv[6], kv[7]);
            b.x = cvt_pk(kv[8], kv[9]); b.y = cvt_pk(kv[10], kv[11]); b.z = cvt_pk(kv[12], kv[13]); b.w = cvt_pk(kv[14], kv[15]);
            bf16_t* kd = KN + (size_t)(m0 + row) * 512 + h * 128 + seg * 16; *(u32x4*)kd = a; *(u32x4*)(kd + 8) = b;
#pragma unroll
            for (int j = 0; j < 16; ++j) kp[j] = kv[j];
        }
        if (tid < 128) {
            const int c = tid & 63, dir = tid >> 6, m = m0 + c;
            const float bv = BG[(size_t)m * 16 + dir * 4 + h];
            const float al = BG[(size_t)m * 16 + 8 + dir * 4 + h] + p.a_dt_bias[i * 8 + dir * 4 + h];
            const float sp = al > 20.f ? al : log1pf(__expf(al));
            BETA[(size_t)(dir * 4 + h) * NTOK + m] = 1.f / (1.f + __expf(-bv));
            GG[(size_t)(dir * 4 + h) * NTOK + m] = -__expf(p.a_log[i * 8 + dir * 4 + h]) * sp;
        }
        __syncthreads();
        {
            u32x4 a, b; LAS float* kc = KF + (c0) * 132 + d;
            a.x = cvt_pk(kc[0 * 132], kc[1 * 132]); a.y = cvt_pk(kc[2 * 132], kc[3 * 132]); a.z = cvt_pk(kc[4 * 132], kc[5 * 132]); a.w = cvt_pk(kc[6 * 132], kc[7 * 132]);
            b.x = cvt_pk(kc[8 * 132], kc[9 * 132]); b.y = cvt_pk(kc[10 * 132], kc[11 * 132]); b.z = cvt_pk(kc[12 * 132], kc[13 * 132]); b.w = cvt_pk(kc[14 * 132], kc[15 * 132]);
            bf16_t* dst = KNT + ((size_t)(tb * 4 + h) * 128 + d) * 64 + c0; *(u32x4*)dst = a; *(u32x4*)(dst + 8) = b;
        }
        __syncthreads();
    }
    bf16_t* PW = (bf16_t*)(ws_ + WS_D);
    const int gw = bid * 8 + wave, NGW = G * 8;
    const int axis = lane >> 5, f = lane & 31;
    const float inv = exp2f(-(float)f * (13.287712379549449f / 32.f));
    for (int m = NPR + gw; m < NTOK; m += NGW) {
        const int t = (m - NPR) & 2047; const float pos = (float)(axis ? (t & 63) : (t >> 6));
        const float ang = pos * inv, cs = __cosf(ang), sn = __sinf(ang);
        bf16_t* base = PW + (size_t)m * EVLD + 2048 + axis * 64 + f;
#pragma unroll
        for (int hh = 0; hh < 6; ++hh) { bf16_t* q = base + hh * 128; const float x1 = bf2f(q[0]), x2 = bf2f(q[32]);
            q[0] = (bf16_t)f2bf(x1 * cs - x2 * sn); q[32] = (bf16_t)f2bf(x2 * cs + x1 * sn); }
    }
}

__device__ __forceinline__ void e3b_phase(const Params& p, unsigned char* lds_raw, int tid, int lane, int wave, int bid, int G) {
    asm volatile("" : "+s"(bid), "+s"(G), "+s"(wave));
    asm volatile("" : "+v"(tid), "+v"(lane));
    size_t zo_ = 0; asm volatile("" : "+s"(zo_)); unsigned char* ws_ = p.ws + zo_;
    const bf16_t* QN = (const bf16_t*)(ws_ + WS_QN); const bf16_t* KN = (const bf16_t*)(ws_ + WS_KN); const bf16_t* VN = (const bf16_t*)(ws_ + WS_VN);
    const float* BETA = (const float*)(ws_ + WS_BETA); const float* GG = (const float*)(ws_ + WS_G); float* GC = (float*)(ws_ + WS_GC);
    bf16_t* U = (bf16_t*)(ws_ + WS_U); bf16_t* Wb = (bf16_t*)(ws_ + WS_W); bf16_t* QK = (bf16_t*)(ws_ + WS_QK);
    const int half = wave >> 2, hw = wave & 3, ht = tid & 255;
    LAS unsigned char* lds = (LAS unsigned char*)lds_raw + half * 62464;
    const bf16_t* KNT = (const bf16_t*)(ws_ + WS_KNT);
    LAS bf16_t* KB = (LAS bf16_t*)lds;
    LAS bf16_t* QB = (LAS bf16_t*)(lds + 17408);
    LAS float* Af = (LAS float*)(lds + 34816);
    LAS float* gcl = (LAS float*)(lds + 52224);
    LAS float* betal = gcl + 64;
    u32x4 kreg[4], qreg[4];
#define E3B_LOAD(pp) do { const int it_ = 2 * (pp) + half; const int dir_ = it_ & 1, h_ = (it_ >> 1) & 3, m0_ = (it_ >> 3) * 64; \
    _Pragma("unroll") for (int j_ = 0; j_ < 4; ++j_) { const int id_ = ht + 256 * j_, c_ = id_ >> 4, seg_ = id_ & 15, tau_ = dir_ ? 63 - c_ : c_; \
        kreg[j_] = *(const u32x4*)(KN + (size_t)(m0_ + tau_) * 512 + h_ * 128 + seg_ * 8); \
        qreg[j_] = *(const u32x4*)(QN + (size_t)(m0_ + tau_) * 512 + h_ * 128 + seg_ * 8); } } while (0)
    if (bid < 768) E3B_LOAD(bid);
    for (int pit = bid; pit < 768; pit += G) {
        const int it = 2 * pit + half;
        const int dir = it & 1, h = (it >> 1) & 3, tb = it >> 3, m0 = tb * 64;
#pragma unroll
        for (int j = 0; j < 4; ++j) { const int id = ht + 256 * j, c = id >> 4, seg = id & 15;
            *(LAS u32x4*)(KB + c * 136 + seg * 8) = kreg[j];
            *(LAS u32x4*)(QB + c * 136 + seg * 8) = qreg[j]; }
        const int fr5 = lane & 15, fq5 = lane >> 4;
        const bf16_t* vb = VN + (size_t)(tb * 4 + h) * 128 * 64; const bf16_t* kb = KNT + (size_t)(tb * 4 + h) * 128 * 64;
        bf16x8 bvf[2][2], bkf[2][2];
#pragma unroll
        for (int t2 = 0; t2 < 2; ++t2)
#pragma unroll
            for (int kk = 0; kk < 2; ++kk) { const size_t o5 = (size_t)((2 * hw + t2) * 16 + fr5) * 64 + kk * 32 + fq5 * 8;
                bvf[t2][kk] = *(const bf16x8*)(vb + o5); bkf[t2][kk] = *(const bf16x8*)(kb + o5); }
        if (hw == 0) { const int tau = dir ? 63 - lane : lane; const size_t gi = (size_t)(dir * 4 + h) * NTOK + m0 + tau;
            float gv = GG[gi];
#pragma unroll
            for (int o = 1; o < 64; o <<= 1) { const float t = __shfl_up(gv, o); if (lane >= o) gv += t; }
            gcl[lane] = gv; betal[lane] = BETA[gi]; GC[gi] = gv; }
        __syncthreads();
        {
            const int fr = lane & 15, fq = lane >> 4;
#pragma unroll 1
            for (int j = 0; j < 8; ++j) {
                const int id = hw * 8 + j, mat = id >> 4, tr = (id >> 2) & 3, tc = id & 3;
                if (mat == 0 && tc > tr) continue;
                const LAS bf16_t* Ap = (mat ? QB : KB) + (tr * 16 + fr) * 136 + fq * 8;
                const LAS bf16_t* Bp = KB + (tc * 16 + fr) * 136 + fq * 8;
                f32x4 acc = {0.f, 0.f, 0.f, 0.f};
#pragma unroll
                for (int kk = 0; kk < 4; ++kk) acc = __builtin_amdgcn_mfma_f32_16x16x32_bf16(*(const LAS bf16x8*)(Ap + kk * 32), *(const LAS bf16x8*)(Bp + kk * 32), acc, 0, 0, 0);
                const int s = tc * 16 + fr; const float gs = gcl[s];
#pragma unroll
                for (int r = 0; r < 4; ++r) { const int c = tr * 16 + fq * 4 + r; const float dec = __expf(fminf(gcl[c] - gs, 0.f));
                    if (mat == 0) Af[c * 68 + s] = (s < c) ? betal[c] * acc[r] * dec : 0.f;
                    else { const int tc_ = dir ? 63 - c : c, ts_ = dir ? 63 - s : s;
                        QK[((size_t)((dir * 192 + tb) * 4 + h) * 64 + tc_) * 64 + ts_] = (bf16_t)f2bf((s <= c) ? acc[r] * dec : 0.f); } }
            }
        }
        __syncthreads();
        LAS float* Mf = (LAS float*)(lds + 17408);
        LAS bf16_t* MU = (LAS bf16_t*)lds;
        LAS float* Tm = (LAS float*)(lds + 9216);
        LAS bf16_t* MW = (LAS bf16_t*)(lds + 52736);
        if (ht < 64) {
            const int blk = ht >> 5, j = ht & 31;
            const LAS float* Ab = Af + blk * (32 * 68 + 32);
            float x[32];
#pragma unroll
            for (int r = 0; r < 32; ++r) {
                float a0 = (r == j) ? 1.f : 0.f, a1 = 0.f, a2 = 0.f, a3 = 0.f;
#pragma unroll
                for (int q = 0; q < (r + 3) / 4; ++q) { const f32x4 av = *(const LAS f32x4*)(Ab + r * 68 + 4 * q);
                    a0 -= av.x * x[4 * q];
                    if (4 * q + 1 < r) a1 -= av.y * x[4 * q + 1];
                    if (4 * q + 2 < r) a2 -= av.z * x[4 * q + 2];
                    if (4 * q + 3 < r) a3 -= av.w * x[4 * q + 3]; }
                x[r] = (a0 + a1) + (a2 + a3);
            }
            LAS float* Mb = Mf + blk * (32 * 68 + 32) + j;
#pragma unroll
            for (int r = 0; r < 32; ++r) Mb[r * 68] = x[r];
        }
        __syncthreads();
        const int br = ht >> 3, bc0 = (ht & 7) * 4;
        {
            f32x4 t = {0.f, 0.f, 0.f, 0.f};
#pragma unroll 8
            for (int q = 0; q < 32; ++q) { const float lv = Af[(32 + br) * 68 + q]; const f32x4 dvv = *(const LAS f32x4*)(Mf + q * 68 + bc0); t = t + dvv * lv; }
            *(LAS f32x4*)(Tm + br * 36 + bc0) = t;
        }
        __syncthreads();
        {
            f32x4 m = {0.f, 0.f, 0.f, 0.f};
#pragma unroll 8
            for (int q = 0; q < 32; ++q) { const float dd = Mf[(32 + br) * 68 + 32 + q]; const f32x4 tt = *(const LAS f32x4*)(Tm + q * 36 + bc0); m = m - tt * dd; }
            *(LAS f32x4*)(Mf + (32 + br) * 68 + bc0) = m;
        }
        __syncthreads();
        {
            const int c = ht >> 2, s0 = (ht & 3) * 16;
#pragma unroll
            for (int k = 0; k < 16; ++k) { const int sidx = s0 + k;
                const float mld = Mf[c * 68 + sidx]; const float m = (c < 32 && sidx >= 32) ? 0.f : mld;
                const float mu = m * betal[sidx], mw = mu * __expf(gcl[sidx]);
                const int tau = dir ? 63 - sidx : sidx;
                MU[c * 72 + tau] = (bf16_t)f2bf(mu); MW[c * 72 + tau] = (bf16_t)f2bf(mw); }
        }
        __syncthreads();
        {
            const int fr = lane & 15, fq = lane >> 4;
            float zl = 0.f; asm volatile("" : "+v"(zl));
            if (pit + G < 768) E3B_LOAD(pit + G);
#pragma unroll
            for (int t2 = 0; t2 < 2; ++t2) {
                const int jcol = (2 * hw + t2) * 16 + fr;
                bf16x8 bv[2], bk[2];
#pragma unroll
                for (int kk = 0; kk < 2; ++kk) { bv[kk] = bvf[t2][kk]; bk[kk] = bkf[t2][kk]; }
#pragma unroll 1
                for (int tr = 0; tr < 4; ++tr) {
                    f32x4 au = {0.f, 0.f, 0.f, 0.f}, aw = {0.f, 0.f, 0.f, 0.f};
#pragma unroll
                    for (int kk = 0; kk < 2; ++kk) {
                        au = __builtin_amdgcn_mfma_f32_16x16x32_bf16(*(const LAS bf16x8*)(MU + (tr * 16 + fr) * 72 + fq * 8 + kk * 32), bv[kk], au, 0, 0, 0);
                        aw = __builtin_amdgcn_mfma_f32_16x16x32_bf16(*(const LAS bf16x8*)(MW + (tr * 16 + fr) * 72 + fq * 8 + kk * 32), bk[kk], aw, 0, 0, 0); }
#pragma unroll
                    for (int r = 0; r < 4; ++r) { const int c = tr * 16 + fq * 4 + r, tauc = dir ? 63 - c : c;
                        const size_t o = ((size_t)dir * NTOK + m0 + tauc) * 512 + h * 128 + jcol;
                        U[o] = (bf16_t)f2bf(au[r] + zl); Wb[o] = (bf16_t)f2bf(aw[r] + zl); }
                }
            }
        }
        __syncthreads();
    }
}

#undef E3B_LOAD
__device__ __forceinline__ void scan_item(const Params& p, int i, int seq, int dir, int h, int sl, unsigned char* lds_raw, int tid, int lane, int wave) {
    asm volatile("" : "+s"(wave));
    asm volatile("" : "+v"(tid), "+v"(lane));
    size_t zo_ = 0; asm volatile("" : "+s"(zo_)); unsigned char* ws_ = p.ws + zo_;
    const bf16_t* QN = (const bf16_t*)(ws_ + WS_QN); const bf16_t* KNT = (const bf16_t*)(ws_ + WS_KNT);
    const bf16_t* U = (const bf16_t*)(ws_ + WS_U); const bf16_t* Wb = (const bf16_t*)(ws_ + WS_W); const bf16_t* QK = (const bf16_t*)(ws_ + WS_QK);
    const float* GC = (const float*)(ws_ + WS_GC); float* ODN = (float*)(ws_ + WS_ODN);
    LAS unsigned char* lds = (LAS unsigned char*)lds_raw;
    LAS bf16_t* Wl = (LAS bf16_t*)lds;
    LAS bf16_t* QNl = (LAS bf16_t*)(lds + 17408);
    LAS bf16_t* KTl = (LAS bf16_t*)(lds + 34816);
    LAS bf16_t* QKl = (LAS bf16_t*)(lds + 53248);
    LAS float* egc = (LAS float*)(lds + 62464);
    LAS float* egl = egc + 64;
    LAS bf16_t* ST = (LAS bf16_t*)(lds + 63488);
    LAS bf16_t* VNT = (LAS bf16_t*)(lds + 80896);
    LAS bf16_t* VNST = (LAS bf16_t*)(lds + 85504);
    const bool prompt = seq < 16;
    const int mbase = prompt ? seq * 256 : NPR + (seq - 16) * 2048, nblk = prompt ? 4 : 32;
    const int fr = lane & 15, fq = lane >> 4, tr = wave >> 1, tc = wave & 1;
    f32x4 Sacc[2];
    if (prompt) { Sacc[0] = (f32x4){0.f, 0.f, 0.f, 0.f}; Sacc[1] = Sacc[0]; }
    else { const float* s0 = p.state_a + ((size_t)(((seq - 16) * 2 + i) * 2 + dir) * 4 + h) * 16384;
#pragma unroll
        for (int eb = 0; eb < 2; ++eb)
#pragma unroll
            for (int r = 0; r < 4; ++r) Sacc[eb][r] = s0[(size_t)(wave * 16 + fq * 4 + r) * 128 + sl * 32 + eb * 16 + fr]; }
#pragma unroll
    for (int eb = 0; eb < 2; ++eb) { u32x2 w; w.x = cvt_pk(Sacc[eb][0], Sacc[eb][1]); w.y = cvt_pk(Sacc[eb][2], Sacc[eb][3]);
        *(LAS u32x2*)(ST + (eb * 16 + fr) * 136 + wave * 16 + fq * 4) = w; }
    u32x4 wreg[2], qreg[2], kreg[2], qkreg; unsigned ureg[4]; float gcv = 0.f, glast = 0.f;
#define SCAN_LOAD(n) do { const int tb_ = dir ? nblk - 1 - (n) : (n); const int m0_ = mbase + tb_ * 64; const int tbg_ = m0_ >> 6; \
    _Pragma("unroll") for (int j_ = 0; j_ < 2; ++j_) { const int id_ = tid + 512 * j_; \
        wreg[j_] = *(const u32x4*)(Wb + ((size_t)dir * NTOK + m0_ + (id_ >> 4)) * 512 + h * 128 + (id_ & 15) * 8); \
        qreg[j_] = *(const u32x4*)(QN + (size_t)(m0_ + (id_ >> 4)) * 512 + h * 128 + (id_ & 15) * 8); \
        kreg[j_] = *(const u32x4*)(KNT + ((size_t)(tbg_ * 4 + h) * 128 + (id_ >> 3)) * 64 + (id_ & 7) * 8); } \
    qkreg = *(const u32x4*)(QK + ((size_t)((dir * 192 + tbg_) * 4 + h) * 64 + (tid >> 3)) * 64 + (tid & 7) * 8); \
    _Pragma("unroll") for (int r_ = 0; r_ < 4; ++r_) ureg[r_] = U[((size_t)dir * NTOK + m0_ + tr * 16 + fq * 4 + r_) * 512 + h * 128 + sl * 32 + tc * 16 + fr]; \
    gcv = GC[(size_t)(dir * 4 + h) * NTOK + m0_ + (tid & 63)]; glast = GC[(size_t)(dir * 4 + h) * NTOK + m0_ + (dir ? 0 : 63)]; } while (0)
    SCAN_LOAD(0);
    int cur = 0;
    float zlaund = 0.f; asm volatile("" : "+v"(zlaund));
    for (int n = 0; n < nblk; ++n) {
        const int tb = dir ? nblk - 1 - n : n, m0 = mbase + tb * 64;
#pragma unroll
        for (int j = 0; j < 2; ++j) { const int id = tid + 512 * j;
            *(LAS u32x4*)(Wl + (id >> 4) * 136 + (id & 15) * 8) = wreg[j];
            *(LAS u32x4*)(QNl + (id >> 4) * 136 + (id & 15) * 8) = qreg[j];
            *(LAS u32x4*)(KTl + (id >> 3) * 72 + (id & 7) * 8) = kreg[j]; }
        *(LAS u32x4*)(QKl + (tid >> 3) * 72 + (tid & 7) * 8) = qkreg;
        if (tid < 64) { egc[tid] = __expf(gcv); egl[tid] = __expf(glast - gcv); }
        const float eg = __expf(glast);
        float uv[4];
#pragma unroll
        for (int r = 0; r < 4; ++r) uv[r] = bf2f(ureg[r]);
        __syncthreads();
        if (n + 1 < nblk) SCAN_LOAD(n + 1);
        f32x4 aws = {0.f, 0.f, 0.f, 0.f}, aqs = {0.f, 0.f, 0.f, 0.f};
        {
            const LAS bf16_t* Sp = ST + cur * (32 * 136) + (tc * 16 + fr) * 136 + fq * 8;
            const LAS bf16_t* Wp = Wl + (tr * 16 + fr) * 136 + fq * 8;
            const LAS bf16_t* Qp = QNl + (tr * 16 + fr) * 136 + fq * 8;
#pragma unroll
            for (int kk = 0; kk < 4; ++kk) { const bf16x8 sb = *(const LAS bf16x8*)(Sp + kk * 32);
                aws = __builtin_amdgcn_mfma_f32_16x16x32_bf16(*(const LAS bf16x8*)(Wp + kk * 32), sb, aws, 0, 0, 0);
                aqs = __builtin_amdgcn_mfma_f32_16x16x32_bf16(*(const LAS bf16x8*)(Qp + kk * 32), sb, aqs, 0, 0, 0); }
        }
        float vn[4], el[4], ec[4];
#pragma unroll
        for (int r = 0; r < 4; ++r) { const int c = tr * 16 + fq * 4 + r; vn[r] = uv[r] - aws[r]; el[r] = egl[c]; ec[r] = egc[c]; }
        { u32x2 w; w.x = cvt_pk(vn[0], vn[1]); w.y = cvt_pk(vn[2], vn[3]); *(LAS u32x2*)(VNT + (tc * 16 + fr) * 72 + tr * 16 + fq * 4) = w;
          w.x = cvt_pk(vn[0] * el[0], vn[1] * el[1]); w.y = cvt_pk(vn[2] * el[2], vn[3] * el[3]); *(LAS u32x2*)(VNST + (tc * 16 + fr) * 72 + tr * 16 + fq * 4) = w; }
        __syncthreads();
        {
            f32x4 ao = {0.f, 0.f, 0.f, 0.f};
            const LAS bf16_t* Ap = QKl + (tr * 16 + fr) * 72 + fq * 8;
            const LAS bf16_t* Bp = VNT + (tc * 16 + fr) * 72 + fq * 8;
#pragma unroll
            for (int kk = 0; kk < 2; ++kk) ao = __builtin_amdgcn_mfma_f32_16x16x32_bf16(*(const LAS bf16x8*)(Ap + kk * 32), *(const LAS bf16x8*)(Bp + kk * 32), ao, 0, 0, 0);
            float* od = ODN + ((size_t)dir * NTOK + m0 + tr * 16 + fq * 4) * 512 + h * 128 + sl * 32 + tc * 16 + fr;
#pragma unroll
            for (int r = 0; r < 4; ++r) od[(size_t)r * 512] = ec[r] * aqs[r] + ao[r];
        }
        {
            const LAS bf16_t* Ap = KTl + (wave * 16 + fr) * 72 + fq * 8;
#pragma unroll
            for (int eb = 0; eb < 2; ++eb) {
                const LAS bf16_t* Bp = VNST + (eb * 16 + fr) * 72 + fq * 8;
                f32x4 a = Sacc[eb] * eg;
#pragma unroll
                for (int kk = 0; kk < 2; ++kk) a = __builtin_amdgcn_mfma_f32_16x16x32_bf16(*(const LAS bf16x8*)(Ap + kk * 32), *(const LAS bf16x8*)(Bp + kk * 32), a, 0, 0, 0);
                Sacc[eb] = a;
                const float b0 = a[0] + zlaund, b1 = a[1] + zlaund, b2 = a[2] + zlaund, b3 = a[3] + zlaund;
                u32x2 w; w.x = cvt_pk(b0, b1); w.y = cvt_pk(b2, b3);
                *(LAS u32x2*)(ST + (cur ^ 1) * (32 * 136) + (eb * 16 + fr) * 136 + wave * 16 + fq * 4) = w;
            }
        }
        cur ^= 1;
        __syncthreads();
    }
#undef SCAN_LOAD
    if (prompt) { float* so = p.out + OUT_STATE + ((size_t)((seq * 2 + i) * 2 + dir) * 4 + h) * 16384;
#pragma unroll
        for (int eb = 0; eb < 2; ++eb)
#pragma unroll
            for (int r = 0; r < 4; ++r) so[(size_t)(wave * 16 + fq * 4 + r) * 128 + sl * 32 + eb * 16 + fr] = Sacc[eb][r]; }
}

__device__ __forceinline__ void mixer_phase(const Params& p, int l, unsigned char* lds_raw, int tid, int lane, int wave, int bid, int G) {
    asm volatile("" : "+s"(bid), "+s"(G), "+s"(wave));
    size_t zo_ = 0; asm volatile("" : "+s"(zo_)); unsigned char* ws_ = p.ws + zo_;
    asm volatile("" : "+v"(tid), "+v"(lane));
    const bool even = (l & 1) == 0; const int i = l >> 1;
    const bf16_t* PROJ = (const bf16_t*)(ws_ + WS_D); bf16_t* MIX = (bf16_t*)(ws_ + WS_MIX);
    const int nitems = even ? 832 : 384;
    const int vb = (G % 8 == 0) ? (bid % 8) * (G / 8) + bid / 8 : bid;
    const bool dyn = even && G == 256;
    unsigned* qcnt = (unsigned*)p.ws + 3600 + 64 * i;
    volatile LAS unsigned* qword = (volatile LAS unsigned*)((LAS unsigned char*)lds_raw + 131072 + 64 + 16);
    for (int q = vb; q < nitems; ) {
        const int it = dyn ? (q < 128 ? 128 + q : (q < 256 ? q - 128 : q)) : q;
        int kind;
        int b = 0, hq = 0, qb = 0, seq = 0, dir = 0, hh = 0, sl = 0;
        if (even) {
            if (it < 128) { kind = 0; b = it >> 5; hq = (it >> 3) & 3; qb = it & 7; }
            else if (it < 256) { kind = 2; const int j = it - 128; sl = j & 3; hh = (j >> 2) & 3; dir = (j >> 4) & 1; seq = 16 + (j >> 5); }
            else if (it < 320) { kind = 1; const int j = it - 256; b = j >> 2; hq = j & 3; }
            else { kind = 2; const int j = it - 320; sl = j & 3; hh = (j >> 2) & 3; dir = (j >> 4) & 1; seq = j >> 5; }
        } else {
            if (it < 256) { kind = 0; b = it >> 6; hq = (it >> 3) & 7; qb = it & 7; }
            else { kind = 1; const int j = it - 256; b = j >> 3; hq = j & 7; }
        }
        if (kind == 2) scan_item(p, i, seq, dir, hh, sl, lds_raw, tid, lane, wave);
        else {
        const int ld = even ? EVLD : ODN;
        const int qcol = even ? 2048 + hq * 128 : hq * 128;
        const int kvh = even ? (hq >> 1) : (hq >> 2);
        const int kcol = even ? 2560 + kvh * 128 : 1024 + kvh * 128;
        const int vcol = even ? 2816 + kvh * 128 : 1280 + kvh * 128;
        const int ocol = even ? 512 + hq * 128 : hq * 128;
        const float m_init = even ? p.b_sink[i * 4 + hq] / SCALE : -1e30f, l_init = even ? 1.f : 0.f;
        if (kind == 1) {
            const int m0 = b * 256;
            att::attn_body<false>(PROJ + (size_t)m0 * ld + qcol, ld, nullptr, nullptr, 0, 0, PROJ + (size_t)m0 * ld + kcol, PROJ + (size_t)m0 * ld + vcol, ld, 4,
                                  MIX + (size_t)m0 * DM + ocol, DM, m_init, l_init, 0, (char*)lds_raw);
        } else {
            const int s0 = NPR + b * 2048, m0 = s0 + qb * 256;
            const bf16_t* ctx = (const bf16_t*)(ws_ + (even ? WS_CTXB : WS_CTXC)) + (size_t)((b * 2 + i) * 2) * 512 * 256 + kvh * 128;
            if (even) {
                const int loc0 = qb == 0 ? 0 : qb * 256 - 128; const int loce = qb == 7 ? 2048 : qb * 256 + 384; const int nlt = (loce - loc0) >> 6;
                att::attn_body<true>(PROJ + (size_t)m0 * ld + qcol, ld, ctx, ctx + (size_t)512 * 256, 256, 8,
                                     PROJ + (size_t)(s0 + loc0) * ld + kcol, PROJ + (size_t)(s0 + loc0) * ld + vcol, ld, 8 + nlt,
                                     MIX + (size_t)m0 * DM + ocol, DM, m_init, l_init, qb * 256 - loc0, (char*)lds_raw);
            } else {
                att::attn_body<false>(PROJ + (size_t)m0 * ld + qcol, ld, ctx, ctx + (size_t)512 * 256, 256, 8,
                                      PROJ + (size_t)s0 * ld + kcol, PROJ + (size_t)s0 * ld + vcol, ld, 40,
                                      MIX + (size_t)m0 * DM + ocol, DM, m_init, l_init, 0, (char*)lds_raw);
            }
        }
        }
        if (dyn) {
            if (tid == 0) *qword = 256u + __hip_atomic_fetch_add(qcnt, 1u, __ATOMIC_RELAXED, __HIP_MEMORY_SCOPE_AGENT);
            __syncthreads();
            q = (int)*qword;
            __syncthreads();
        } else q += G;
    }
}

__device__ __forceinline__ void e5_phase(const Params& p, int i, int gw, int NGW, int lane) {
    asm volatile("" : "+s"(gw), "+s"(NGW));
    size_t zo_ = 0; asm volatile("" : "+s"(zo_)); unsigned char* ws_ = p.ws + zo_;
    asm volatile("" : "+v"(lane));
    const float* ODN = (const float*)(ws_ + WS_ODN); const bf16_t* PROJ = (const bf16_t*)(ws_ + WS_D); bf16_t* MIX = (bf16_t*)(ws_ + WS_MIX);
    const float* ng = p.a_norm_g + i * 128 + (lane & 15) * 8;
    const f32x4 g0 = *(const f32x4*)ng, g1 = *(const f32x4*)(ng + 4);
    for (int m = gw; m < NTOK; m += NGW) {
        const float* pa = ODN + (size_t)m * 512 + lane * 8; const float* pb = ODN + ((size_t)NTOK + m) * 512 + lane * 8;
        const f32x4 a0 = *(const f32x4*)pa, a1 = *(const f32x4*)(pa + 4), b0 = *(const f32x4*)pb, b1 = *(const f32x4*)(pb + 4);
        const u32x4 gt = *(const u32x4*)(PROJ + (size_t)m * EVLD + 1536 + lane * 8);
        float o[8], gv[8];
#pragma unroll
        for (int j = 0; j < 4; ++j) { o[j] = a0[j] + b0[j]; o[4 + j] = a1[j] + b1[j]; }
        gv[0] = bflo(gt.x); gv[1] = bfhi(gt.x); gv[2] = bflo(gt.y); gv[3] = bfhi(gt.y); gv[4] = bflo(gt.z); gv[5] = bfhi(gt.z); gv[6] = bflo(gt.w); gv[7] = bfhi(gt.w);
        float ss = 0.f;
#pragma unroll
        for (int j = 0; j < 8; ++j) ss += o[j] * o[j];
        ss += __shfl_xor(ss, 1); ss += __shfl_xor(ss, 2); ss += __shfl_xor(ss, 4); ss += __shfl_xor(ss, 8);
        const float rstd = rsqrtf(ss * (1.f / 128.f) + EPS);
        float y[8];
#pragma unroll
        for (int j = 0; j < 8; ++j) y[j] = o[j] * rstd * (j < 4 ? g0[j] : g1[j - 4]) * silu_f(gv[j]);
        u32x4 w; w.x = cvt_pk(y[0], y[1]); w.y = cvt_pk(y[2], y[3]); w.z = cvt_pk(y[4], y[5]); w.w = cvt_pk(y[6], y[7]);
        *(u32x4*)(MIX + (size_t)m * DM + lane * 8) = w;
    }
}

__device__ __forceinline__ void o3_phase(const Params& p, int i, int gw, int NGW, int lane) {
    asm volatile("" : "+s"(gw), "+s"(NGW));
    size_t zo_ = 0; asm volatile("" : "+s"(zo_)); unsigned char* ws_ = p.ws + zo_;
    asm volatile("" : "+v"(lane));
    bf16_t* PW = (bf16_t*)(ws_ + WS_D);
    const int axis = lane >> 5, f = lane & 31, d1 = axis * 64 + f, d2 = d1 + 32;
    const float inv = exp2f(-(float)f * (13.287712379549449f / 32.f));
    const float gq1 = p.c_qnorm_g[i * 128 + d1], gq2 = p.c_qnorm_g[i * 128 + d2], gk1 = p.c_knorm_g[i * 128 + d1], gk2 = p.c_knorm_g[i * 128 + d2];
    for (int m = gw; m < NTOK; m += NGW) {
        const bool smp = m >= NPR;
        float cs = 1.f, sn = 0.f;
        if (smp) { const int t = (m - NPR) & 2047; const float pos = (float)(axis ? (t & 63) : (t >> 6)); const float ang = pos * inv; cs = __cosf(ang); sn = __sinf(ang); }
        bf16_t* row = PW + (size_t)m * ODN;
#pragma unroll
        for (int hh = 0; hh < 10; ++hh) {
            bf16_t* q = row + hh * 128;
            const float x1 = bf2f(q[d1]), x2 = bf2f(q[d2]);
            const float rstd = rsqrtf(wave_sum(x1 * x1 + x2 * x2) * (1.f / 128.f) + EPS);
            const float y1 = x1 * rstd * (hh < 8 ? gq1 : gk1), y2 = x2 * rstd * (hh < 8 ? gq2 : gk2);
            if (!smp && hh >= 8) { float* co = p.out + OUT_CC + ((size_t)(((m >> 8) * 2 + i) * 2) * 256 + (m & 255)) * 256 + (hh - 8) * 128; co[d1] = y1; co[d2] = y2; }
            q[d1] = (bf16_t)f2bf(y1 * cs - y2 * sn); q[d2] = (bf16_t)f2bf(y2 * cs + y1 * sn);
        }
    }
}


#define XB_TMO      128
#define XB_XCNT(j)  (256  + 64 * (j))
#define XB_XSUB(j)  (1280 + 64 * (j))
#define XB_XGEN(j)  (2304 + 64 * (j))
#define XB_TOP      3328
#define XB_TOPGEN   3392
#define XCD_BAR_WORDS 3456
#define XB_SPIN_CAP (1u << 18)
__device__ __forceinline__ unsigned xb_ld(unsigned* p)              { return __hip_atomic_load(p, __ATOMIC_RELAXED, __HIP_MEMORY_SCOPE_AGENT); }
__device__ __forceinline__ unsigned xb_add(unsigned* p, unsigned v) { return __hip_atomic_fetch_add(p, v, __ATOMIC_RELAXED, __HIP_MEMORY_SCOPE_AGENT); }
__device__ __forceinline__ unsigned xb_xcc_id() { return (unsigned)__builtin_amdgcn_s_getreg((3 << 11) | 20) & 0xFu; }
#define XB_SPIN(cond, bar) do { unsigned _sp = 0; while (cond) { __builtin_amdgcn_s_sleep(1); \
    if ((++_sp & 255u) == 0u) { if (xb_ld(&(bar)[XB_TMO])) break; if (_sp > XB_SPIN_CAP) { atomicAdd(&(bar)[XB_TMO], 1u); break; } } } } while (0)
struct XcdBarrier { unsigned* bar; unsigned x; volatile LAS unsigned* st; };
__device__ __forceinline__ XcdBarrier xcd_barrier_post(unsigned* bar, volatile LAS unsigned* st) {
    XcdBarrier b; b.bar = bar; b.x = xb_xcc_id(); b.st = st;
    if (threadIdx.x == 0) (void)xb_add(&bar[XB_XCNT(b.x)], 1u);
    return b;
}
__device__ __forceinline__ void xcd_barrier_complete(unsigned* bar, unsigned x, unsigned& nloc, unsigned& nx) {
    const unsigned G = gridDim.x * gridDim.y * gridDim.z;
    unsigned sum, cnt, mine, sp = 0u;
    for (;;) {
        sum = 0u; cnt = 0u; mine = 0u;
#pragma unroll
        for (unsigned j = 0; j < 16; ++j) { const unsigned c = xb_ld(&bar[XB_XCNT(j)]); sum += c; cnt += (c > 0u) ? 1u : 0u; mine = (j == x) ? c : mine; }
        if (sum == G) break;
        __builtin_amdgcn_s_sleep(1);
        if ((++sp & 255u) == 0u) { if (xb_ld(&bar[XB_TMO])) break; if (sp > XB_SPIN_CAP) { atomicAdd(&bar[XB_TMO], 1u); break; } }
    }
    nloc = mine > 0u ? mine : 1u; nx = cnt > 0u ? cnt : 1u;
}
__device__ __forceinline__ void xcd_barrier(const XcdBarrier& b) {
    asm volatile("s_waitcnt vmcnt(0)" ::: "memory");
    __syncthreads();
    if (threadIdx.x == 0) {
        unsigned* bar = b.bar;
        __builtin_amdgcn_s_waitcnt(0);
        unsigned nloc = b.st[0], nx = b.st[1];
        if (nloc == 0u) { xcd_barrier_complete(bar, b.x, nloc, nx); b.st[0] = nloc; b.st[1] = nx; }
        const unsigned old = xb_add(&bar[XB_XSUB(b.x)], 1u);
        const unsigned gen = old / nloc;
        if (old + 1u == (gen + 1u) * nloc) {
            __builtin_amdgcn_fence(__ATOMIC_RELEASE, "agent");
            asm volatile("s_waitcnt vmcnt(0)" ::: "memory");
            const unsigned og = xb_add(&bar[XB_TOP], 1u);
            const unsigned tg = og / nx;
            if (og + 1u == (tg + 1u) * nx) xb_add(&bar[XB_TOPGEN], 1u);
            else XB_SPIN(xb_ld(&bar[XB_TOPGEN]) == tg, bar);
            __builtin_amdgcn_fence(__ATOMIC_ACQUIRE, "agent");
            xb_add(&bar[XB_XGEN(b.x)], 1u);
            asm volatile("s_waitcnt vmcnt(0)" ::: "memory");
        } else {
            XB_SPIN(xb_ld(&bar[XB_XGEN(b.x)]) == gen, bar);
            __builtin_amdgcn_fence(__ATOMIC_ACQUIRE, "agent");
            asm volatile("s_waitcnt vmcnt(0)" ::: "memory");
        }
    }
    __syncthreads();
}
__global__ void __launch_bounds__(512, 2) mega_fwd(Params p) {
    extern __shared__ __attribute__((aligned(16))) unsigned char lds_raw[];
    cg::grid_group grid = cg::this_grid();
#define GSYNC() do { asm volatile("s_waitcnt vmcnt(0) lgkmcnt(0)" ::: "memory"); grid.sync(); __builtin_amdgcn_fence(__ATOMIC_ACQUIRE, "agent"); asm volatile("s_waitcnt vmcnt(0)" ::: "memory"); } while (0)
    const int tid = threadIdx.x, lane = tid & 63, wave = __builtin_amdgcn_readfirstlane(tid >> 6);
    const int G = gridDim.x, bid = blockIdx.x, gw = bid * 8 + wave, NGW = G * 8;

    volatile LAS unsigned* misc = (volatile LAS unsigned*)((LAS unsigned char*)lds_raw + 131072 + 64);
    if (tid == 0) { misc[0] = 0u; misc[1] = 0u; }
    __syncthreads();
    (void)xcd_barrier_post((unsigned*)p.ws, misc);
    phase0(p, lds_raw, tid, lane, wave, bid, G);
#define XSYNC() do { XcdBarrier xb_; xb_.bar = (unsigned*)p.ws; xb_.x = xb_xcc_id(); xb_.st = (volatile LAS unsigned*)((LAS unsigned char*)lds_raw + 131072 + 64); xcd_barrier(xb_); } while (0)
    if (p.ws == nullptr) GSYNC();
    XSYNC();
#pragma unroll 1
    for (int l = 0; l < NLAYERS; ++l) {
        const bool even = (l & 1) == 0; const int i = l >> 1;
        size_t zo = 0; asm volatile("" : "+s"(zo)); unsigned char* ws = p.ws + zo; float* X = p.out + zo;
        bf16_t* H = (bf16_t*)(ws + WS_H); bf16_t* MIX = (bf16_t*)(ws + WS_MIX); bf16_t* DBUF = (bf16_t*)(ws + WS_D);
        const float* modl = (const float*)(ws + WS_MOD) + (size_t)l * 5 * 6144;
        norm_phase(l == 0 ? p.x_prompt : X, l == 0 ? p.x_sample : X + (size_t)NPR * DM, nullptr, p.norm1_g + l * DM, modl, 0, 1, H, gw, NGW, lane);
        XSYNC();
        {
            const int N = even ? EVN : ODN;
            const bf16_t* Wt = even ? (const bf16_t*)(ws + WS_WEVIN) + (size_t)i * EVN * 1024 : (const bf16_t*)(ws + WS_WODIN) + (size_t)i * ODN * 1024;
            pg8::Gemm g{H, Wt, NTOK, N, DM}; pg8::StaticOrder S; S.init(NTOK, N, G, bid);
            pg8::EpiProj E;
            E.O = DBUF; E.ldc = even ? EVLD : ODN; E.npn_store = even ? 12 : 6;
            E.cache = X + (even ? OUT_CB : OUT_CC) + (size_t)i * 2 * 65536; E.pn_k = even ? 10 : 4; E.pn_lo = even ? 10 : 5; E.pn_hi = even ? 12 : 6;
            E.bg = (float*)(ws + WS_BG); E.pn_bg = even ? 12 : -1;
            pg8::gemm_phase<pg8::EpiProj>((LAS unsigned char*)lds_raw, g, S, E);
        }
        XSYNC();
        if (even) {
            e3a_phase(p, i, lds_raw, tid, lane, wave, bid, G);
            XSYNC();
            e3b_phase(p, lds_raw, tid, lane, wave, bid, G);
            XSYNC();
        } else {
            o3_phase(p, i, gw, NGW, lane);
            XSYNC();
        }
        mixer_phase(p, l, lds_raw, tid, lane, wave, bid, G);
        XSYNC();
        if (even) { e5_phase(p, i, gw, NGW, lane); XSYNC(); }
        {
            const bf16_t* Wt = even ? (const bf16_t*)(ws + WS_WEVOUT) + (size_t)i * 1024 * 1024 : (const bf16_t*)(ws + WS_WODOUT) + (size_t)i * 1024 * 1024;
            pg8::Gemm g{MIX, Wt, NTOK, DM, DM}; pg8::StaticOrder S; S.init(NTOK, DM, G, bid);
            pg8::EpiResid E; E.X = X; E.gate = modl + 2 * 1024; E.xin_p = l == 0 ? p.x_prompt : nullptr; E.xin_s = l == 0 ? p.x_sample : nullptr;
            pg8::gemm_phase<pg8::EpiResid>((LAS unsigned char*)lds_raw, g, S, E);
        }
        XSYNC();
        norm_phase(X, X + (size_t)NPR * DM, nullptr, p.norm2_g + l * DM, modl, 3, 4, H, gw, NGW, lane);
        XSYNC();
        {
            pg8::Gemm g{H, (const bf16_t*)(ws + WS_W1) + (size_t)l * DFF * DM, NTOK, DFF, DM}; pg8::StaticOrder S; S.init(NTOK, DFF, G, bid);
            pg8::EpiAct E; E.O = DBUF; E.ldc = DFF;
            pg8::gemm_phase<pg8::EpiAct>((LAS unsigned char*)lds_raw, g, S, E);
        }
        XSYNC();
        {
            pg8::Gemm g{DBUF, (const bf16_t*)(ws + WS_W2) + (size_t)l * DM * DFF, NTOK, DM, DFF}; pg8::StaticOrder S; S.init(NTOK, DM, G, bid);
            pg8::EpiResid E; E.X = X; E.gate = modl + 5 * 1024; E.xin_p = nullptr; E.xin_s = nullptr;
            const int nun = (NTOK / 256) * (DM / 256);
            if (l + 1 < NLAYERS) {
                if (G > nun) { if (bid >= nun) transpose_layer(p, ws, l + 1, (bid - nun) * 8 + wave, (G - nun) * 8, (LAS float*)((LAS unsigned char*)lds_raw + wave * 9216), lane); }
                else transpose_layer(p, ws, l + 1, bid * 8 + wave, G * 8, (LAS float*)((LAS unsigned char*)lds_raw + wave * 9216), lane);
                if (G <= nun) __syncthreads();
            }
            pg8::gemm_phase<pg8::EpiResid>((LAS unsigned char*)lds_raw, g, S, E);
        }
        XSYNC();
    }
    final_phase(p.out, p.final_g, gw, NGW, lane);
}

extern "C" void kernel_launch(void* const* d_in, const int* in_sizes, int n_in, void* d_out, int out_size, void* d_ws, size_t ws_size, hipStream_t stream) {
    static int grid = 0;
    if (grid == 0) {
        if (n_in != 25 || out_size != 25165824 || ws_size < WS_END) { fprintf(stderr, "kernel_launch: unexpected shapes: n_in %d out %d ws %zu\n", n_in, out_size, ws_size); grid = -1; return; }
        int dev = 0, cus = 0, per_cu = 0;
        hipGetDevice(&dev);
        hipDeviceGetAttribute(&cus, hipDeviceAttributeMultiprocessorCount, dev);
        if (hipFuncSetAttribute((const void*)mega_fwd, hipFuncAttributeMaxDynamicSharedMemorySize, LDS_BYTES) != hipSuccess) { fprintf(stderr, "kernel_launch: hipFuncSetAttribute failed\n"); grid = -1; return; }
        if (hipOccupancyMaxActiveBlocksPerMultiprocessor(&per_cu, (const void*)mega_fwd, 512, LDS_BYTES) != hipSuccess || per_cu < 1) { fprintf(stderr, "kernel_launch: occupancy query says %d\n", per_cu); per_cu = 1; }
        (void)hipGetLastError();
        grid = cus * 1;
    }
    if (grid < 0) return;
    if (hipMemsetAsync(d_ws, 0, 16384, stream) != hipSuccess) { fprintf(stderr, "kernel_launch: memset failed\n"); return; }
    Params p{};
    const float** pp = (const float**)&p;
    for (int k = 0; k < 25; ++k) pp[k] = (const float*)d_in[k];
    p.out = (float*)d_out; p.ws = (unsigned char*)d_ws;
    void* args[] = {&p};
    hipError_t e = hipLaunchCooperativeKernel((const void*)mega_fwd, dim3(grid), dim3(512), args, LDS_BYTES, stream);
    if (e != hipSuccess) fprintf(stderr, "kernel_launch: cooperative launch failed: %s (grid %d)\n", hipGetErrorString(e), grid);
}
```

```cpp
#include <hip/hip_runtime.h>
#include <hip/hip_cooperative_groups.h>
#include <cstdio>
#include <cstdint>
namespace cg = cooperative_groups;

#define LAS __attribute__((address_space(3)))
typedef unsigned short bf16_t;
typedef short bf16x8 __attribute__((ext_vector_type(8)));
typedef short s16x4 __attribute__((ext_vector_type(4)));
typedef float f32x4 __attribute__((ext_vector_type(4)));
typedef float f32x2 __attribute__((ext_vector_type(2)));
typedef float f32x16 __attribute__((ext_vector_type(16)));
typedef unsigned u32x4 __attribute__((ext_vector_type(4)));
typedef unsigned u32x2 __attribute__((ext_vector_type(2)));

constexpr int DM = 1024, NTOK = 12288, NPR = 4096, DFF = 4096;
constexpr int EVN = 3328, EVLD = 3072, ODN = 1536;
constexpr float EPS = 1e-6f;
constexpr float SCALE = 0.088388347648318440f;

constexpr size_t MiB = 1u << 20;
constexpr size_t WS_MOD = 1 * MiB;
constexpr size_t WS_WEVIN = 2 * MiB;
constexpr size_t WS_WEVOUT = 15 * MiB;
constexpr size_t WS_WODIN = 19 * MiB;
constexpr size_t WS_WODOUT = 25 * MiB;
constexpr size_t WS_W1 = 29 * MiB;
constexpr size_t WS_W2 = 61 * MiB;
constexpr size_t WS_CTXB = 93 * MiB;
constexpr size_t WS_CTXC = 97 * MiB;
constexpr size_t WS_H = 101 * MiB;
constexpr size_t WS_MIX = 125 * MiB;
constexpr size_t WS_BG = 149 * MiB;
constexpr size_t WS_BETA = 150 * MiB;
constexpr size_t WS_G = 150 * MiB + 512 * 1024;
constexpr size_t WS_GC = 151 * MiB;
constexpr size_t WS_D = 152 * MiB;
constexpr size_t WS_QN = 224 * MiB;
constexpr size_t WS_KN = 236 * MiB;
constexpr size_t WS_VN = 248 * MiB;
constexpr size_t WS_KNT = 260 * MiB;
constexpr size_t WS_U = 272 * MiB;
constexpr size_t WS_W = 296 * MiB;
constexpr size_t WS_QK = 320 * MiB;
constexpr size_t WS_ODN = 332 * MiB;
constexpr size_t WS_X16 = 356 * MiB;
constexpr size_t WS_END = 380 * MiB;

constexpr size_t OUT_STATE = 12582912, OUT_CB = 16777216, OUT_CC = 20971520;

constexpr int LDS_BYTES = 147456;
#ifndef NLAYERS
#define NLAYERS 4
#endif
#ifndef STOP_PH
#define STOP_PH 99
#endif

__device__ __forceinline__ unsigned cvt_pk(float lo, float hi) { unsigned r; asm volatile("v_cvt_pk_bf16_f32 %0, %1, %2" : "=v"(r) : "v"(lo), "v"(hi)); return r; }
__device__ __forceinline__ unsigned f2bf(float f) { return cvt_pk(f, 0.f) & 0xffffu; }
__device__ __forceinline__ float bf2f(unsigned h) { return __uint_as_float(h << 16); }
__device__ __forceinline__ float bflo(unsigned w) { return __uint_as_float(w << 16); }
__device__ __forceinline__ float bfhi(unsigned w) { return __uint_as_float(w & 0xffff0000u); }
__device__ __forceinline__ float wave_sum(float v) {
#pragma unroll
    for (int o = 1; o < 64; o <<= 1) v += __shfl_xor(v, o);
    return v;
}
__device__ __forceinline__ float silu_f(float x) { return x / (1.f + __expf(-x)); }
#define LDS_WAIT() asm volatile("s_waitcnt lgkmcnt(0)" ::: "memory")

namespace pg8 {
#define PG8_LAS __attribute__((address_space(3)))
constexpr int BM = 256, BK = 64, HALF = 128, HTB = HALF * BK * 2, STAGE_BYTES = 8 * HTB, NXCD = 8, WGM = 8;
__host__ __device__ __forceinline__ int lds_byte(int r, int c) { const int st = (r >> 4) * 2 + (c >> 5), rr = r & 15, cc = c & 31, ob = rr * 64 + cc * 2; return st * 1024 + (ob ^ (((ob >> 9) & 1) << 5)); }
__host__ __device__ __forceinline__ void stage_rc(int b, int& R, int& C) { const int st = b / 1024, sb = b % 1024, swz = sb ^ (((sb >> 9) & 1) << 5); R = (st >> 1) * 16 + swz / 64; C = (st & 1) * 32 + (swz % 64) / 2; }
__host__ __device__ __forceinline__ int perm32(int rho) { const int n = rho >> 4, i = rho & 15; return 8 * (i >> 2) + 4 * n + (i & 3); }
struct Unit { int pm, pn; };
struct Gemm { const bf16_t* A; const bf16_t* Bt; int M, N, K; };
struct StaticOrder {
    int nM, nN, nwg, G, c;
    __device__ void init(int M, int N, int G_, int c_) { nM = M / BM; nN = N / BM; nwg = nM * nN; G = G_; c = c_; }
    __device__ bool next(int i, Unit& u) const {
        const long L = (long)i * G + c; if (L >= nwg) return false;
        int wgid = (int)L; { const int q = nwg / NXCD, r = nwg % NXCD, xcd = wgid % NXCD, off = wgid / NXCD; wgid = (xcd < r ? xcd * (q + 1) : r * (q + 1) + (xcd - r) * q) + off; }
        const int nig = WGM * nN, gid = wgid / nig, fm = gid * WGM, gsz = (nM - fm) < WGM ? (nM - fm) : WGM;
        u.pm = fm + ((wgid % nig) % gsz); u.pn = (wgid % nig) / gsz; return true;
    }
};

struct EpiProj {
    static constexpr bool PERM = true;
    bf16_t* O; int ldc; int npn_store; float* cache; int pn_k, pn_lo, pn_hi; float* bg; int pn_bg;
    __device__ __forceinline__ void operator()(const f32x4 (&acc)[2][2][4][2], const Unit& u, int wr, int wc, int fr, int fq) const {
        const int row0 = u.pm * BM + wr * 64 + fr, colt = u.pn * BM + wc * 32 + 8 * fq;
        const bool st = u.pn < npn_store;
        const bool cf = (u.pm < 16) && (u.pn >= pn_lo) && (u.pn < pn_hi);
        const bool bgf = (u.pn == pn_bg) && (wc == 0) && (fq < 2);
        float* cb = cache + (size_t)(u.pm * 4 + (u.pn - pn_k)) * 65536;
#pragma unroll
        for (int ai = 0; ai < 2; ++ai)
#pragma unroll
            for (int m = 0; m < 4; ++m) {
                const int r = row0 + ai * HALF + m * 16, rt = wr * 64 + fr + ai * HALF + m * 16;
#pragma unroll
                for (int bj = 0; bj < 2; ++bj) {
                    const f32x4 v0 = acc[ai][bj][m][0], v1 = acc[ai][bj][m][1];
                    if (st) { u32x4 w; w.x = cvt_pk(v0[0], v0[1]); w.y = cvt_pk(v0[2], v0[3]); w.z = cvt_pk(v1[0], v1[1]); w.w = cvt_pk(v1[2], v1[3]);
                        *(u32x4*)(O + (size_t)r * ldc + colt + bj * HALF) = w; }
                    if (cf) { float* d = cb + rt * 256 + wc * 32 + 8 * fq + bj * HALF; *(f32x4*)d = v0; *(f32x4*)(d + 4) = v1; }
                    if (bgf && bj == 0) { float* d = bg + (size_t)r * 16 + 8 * fq; *(f32x4*)d = v0; *(f32x4*)(d + 4) = v1; }
                }
            }
    }
};
struct EpiAct {
    static constexpr bool PERM = true;
    bf16_t* O; int ldc;
    __device__ __forceinline__ void operator()(const f32x4 (&acc)[2][2][4][2], const Unit& u, int wr, int wc, int fr, int fq) const {
        const int row0 = u.pm * BM + wr * 64 + fr, colt = u.pn * BM + wc * 32 + 8 * fq;
#pragma unroll
        for (int ai = 0; ai < 2; ++ai)
#pragma unroll
            for (int m = 0; m < 4; ++m) {
                bf16_t* rowp = O + (size_t)(row0 + ai * HALF + m * 16) * ldc + colt;
#pragma unroll
                for (int bj = 0; bj < 2; ++bj) {
                    f32x4 v0 = acc[ai][bj][m][0], v1 = acc[ai][bj][m][1];
#pragma unroll
                    for (int j = 0; j < 4; ++j) { float a = fmaxf(v0[j], 0.f); v0[j] = a * a; float b = fmaxf(v1[j], 0.f); v1[j] = b * b; }
                    u32x4 w; w.x = cvt_pk(v0[0], v0[1]); w.y = cvt_pk(v0[2], v0[3]); w.z = cvt_pk(v1[0], v1[1]); w.w = cvt_pk(v1[2], v1[3]);
                    *(u32x4*)(rowp + bj * HALF) = w;
                }
            }
    }
};
struct EpiResid {
    static constexpr bool PERM = false;
    bf16_t* X; const float* gate; const float* xin_p; const float* xin_s;
    __device__ __forceinline__ void operator()(const f32x4 (&acc)[2][2][4][2], const Unit& u, int wr, int wc, int fr, int fq) const {
        const int row0 = u.pm * BM + wr * 64 + fr, col0 = u.pn * BM + wc * 32 + 4 * fq;
        const int cidx = u.pm < 16 ? 0 : 1 + ((u.pm - 16) >> 3);
        const float* srcb = xin_p ? (u.pm < 16 ? xin_p : xin_s - (size_t)NPR * DM) : nullptr;
        const float* gp = gate + cidx * 6144 + col0;
        f32x4 gv[2][2];
#pragma unroll
        for (int bj = 0; bj < 2; ++bj)
#pragma unroll
            for (int n = 0; n < 2; ++n) gv[bj][n] = *(const f32x4*)(gp + bj * HALF + n * 16);
#pragma unroll
        for (int ai = 0; ai < 2; ++ai)
#pragma unroll
            for (int m = 0; m < 4; ++m) {
                const size_t ro = (size_t)(row0 + ai * HALF + m * 16) * DM + col0;
#pragma unroll
                for (int bj = 0; bj < 2; ++bj)
#pragma unroll
                    for (int n = 0; n < 2; ++n) { f32x4 x;
                        if (srcb) x = *(const f32x4*)(srcb + ro + bj * HALF + n * 16);
                        else { const u32x2 xb = *(const u32x2*)(X + ro + bj * HALF + n * 16); x = (f32x4){bflo(xb.x), bfhi(xb.x), bflo(xb.y), bfhi(xb.y)}; }
                        x = x + gv[bj][n] * acc[ai][bj][m][n];
                        u32x2 w; w.x = cvt_pk(x.x, x.y); w.y = cvt_pk(x.z, x.w); *(u32x2*)(X + ro + bj * HALF + n * 16) = w; }
            }
    }
};

template <class Epi>
__device__ __forceinline__ void gemm_phase(PG8_LAS unsigned char* lds, const Gemm g, const StaticOrder& S, const Epi& E) {
    int tid = threadIdx.x; asm volatile("" : "+v"(tid));
    const int wid = __builtin_amdgcn_readfirstlane(tid >> 6), lane = tid & 63, wr = wid >> 2, wc = wid & 3, fr = lane & 15, fq = lane >> 4;
    const int K = g.K, nt = K / BK;
    unsigned voffA[2], voffB[2];
#pragma unroll
    for (int i = 0; i < 2; ++i) { int R, C; stage_rc(tid * 16 + i * 8192, R, C); const int Rb = Epi::PERM ? ((R & ~31) + perm32(R & 31)) : R;
        voffA[i] = (unsigned)(R * K + C) * 2u; voffB[i] = (unsigned)(Rb * K + C) * 2u; }
    const size_t kstep = (size_t)(BK * 2);
    const size_t hstep = (size_t)HALF * K * 2;
    const size_t tstep = 2 * hstep;
    const unsigned ldsw = (unsigned)wid * 1024u;
    const int aoff = lds_byte(wr * 64 + fr, fq * 8), boff = lds_byte(wc * 32 + fr, fq * 8);
#define PG8_SA(b, h) (((b) * 2 + (h)) * HTB)
#define PG8_SB(b, h) ((4 + (b) * 2 + (h)) * HTB)
#define PG8_STAGE(bufoff, gbase, voff) do { _Pragma("unroll") for (int _i = 0; _i < 2; ++_i) \
        __builtin_amdgcn_global_load_lds((const unsigned*)((const char*)(gbase) + (voff)[_i]), (PG8_LAS unsigned*)(lds + (bufoff) + ldsw + _i * 8192), 16, 0, 0); } while (0)
#define PG8_LDA(dst, b, h) do { _Pragma("unroll") for (int m = 0; m < 4; ++m) _Pragma("unroll") for (int k = 0; k < 2; ++k) dst[m][k] = *(const PG8_LAS bf16x8*)(lds + PG8_SA(b, h) + aoff + m * 2048 + k * 1024); } while (0)
#define PG8_LDB(dst, b, h) do { _Pragma("unroll") for (int n = 0; n < 2; ++n) _Pragma("unroll") for (int k = 0; k < 2; ++k) dst[n][k] = *(const PG8_LAS bf16x8*)(lds + PG8_SB(b, h) + boff + n * 2048 + k * 1024); } while (0)
#define PG8_MMA(ai, bj, At, Bt) do { __builtin_amdgcn_s_setprio(1); _Pragma("unroll") for (int m = 0; m < 4; ++m) _Pragma("unroll") for (int n = 0; n < 2; ++n) _Pragma("unroll") for (int k = 0; k < 2; ++k) \
        acc[ai][bj][m][n] = __builtin_amdgcn_mfma_f32_16x16x32_bf16(Bt[n][k], At[m][k], acc[ai][bj][m][n], 0, 0, 0); __builtin_amdgcn_s_setprio(0); } while (0)
#define PG8_WAIT_V(n) asm volatile("s_waitcnt vmcnt(" #n ")" ::: "memory")
#define PG8_WAIT_L(n) asm volatile("s_waitcnt lgkmcnt(" #n ")" ::: "memory")
#define PG8_BAR __builtin_amdgcn_s_barrier()
#define PG8_SCHED __builtin_amdgcn_sched_barrier(0)
    Unit cur, nxt; int ui = 0;
    if (!S.next(0, cur)) return;
    f32x4 acc[2][2][4][2];
#pragma unroll
    for (int a = 0; a < 2; ++a)
#pragma unroll
        for (int b = 0; b < 2; ++b)
#pragma unroll
            for (int m = 0; m < 4; ++m)
#pragma unroll
                for (int n = 0; n < 2; ++n) acc[a][b][m][n] = (f32x4){0.f, 0.f, 0.f, 0.f};
    bf16x8 At[4][2], B0[2][2], B1[2][2];
    const char* cA = (const char*)g.A + (size_t)cur.pm * tstep; const char* cB = (const char*)g.Bt + (size_t)cur.pn * tstep;
    PG8_STAGE(PG8_SB(0, 0), cB, voffB); PG8_STAGE(PG8_SA(0, 0), cA, voffA); PG8_STAGE(PG8_SB(0, 1), cB + hstep, voffB); PG8_STAGE(PG8_SA(0, 1), cA + hstep, voffA);
    if (wr == 1) PG8_BAR;
    PG8_WAIT_V(4); PG8_BAR;
    PG8_STAGE(PG8_SB(1, 0), cB + kstep, voffB); PG8_STAGE(PG8_SA(1, 0), cA + kstep, voffA); PG8_STAGE(PG8_SB(1, 1), cB + hstep + kstep, voffB);
    PG8_WAIT_V(6); PG8_BAR;
    for (;;) {
        const bool has_next = S.next(ui + 1, nxt);
        const char* nA = has_next ? (const char*)g.A + (size_t)nxt.pm * tstep : cA; const char* nB = has_next ? (const char*)g.Bt + (size_t)nxt.pn * tstep : cB;
        for (int t = 0; t < nt; t += 2) {
            const bool last = (t == nt - 2);
            const char* a1 = cA + (size_t)(t + 1) * kstep;
            const char* a2 = last ? nA : cA + (size_t)(t + 2) * kstep; const char* b2 = last ? nB : cB + (size_t)(t + 2) * kstep;
            const char* a3 = a2 + kstep; const char* b3 = b2 + kstep;
            PG8_LDB(B0, 0, 0); PG8_SCHED; PG8_LDA(At, 0, 0); PG8_STAGE(PG8_SA(1, 1), a1 + hstep, voffA);
            PG8_WAIT_L(8); PG8_BAR; PG8_WAIT_L(0); PG8_MMA(0, 0, At, B0); PG8_BAR; PG8_SCHED;
            PG8_LDB(B1, 0, 1); PG8_STAGE(PG8_SB(0, 0), b2, voffB);
            PG8_BAR; PG8_WAIT_L(0); PG8_MMA(0, 1, At, B1); PG8_BAR;
            PG8_LDA(At, 0, 1); PG8_STAGE(PG8_SA(0, 0), a2, voffA);
            PG8_BAR; PG8_WAIT_L(0); PG8_MMA(1, 0, At, B0); PG8_BAR; PG8_SCHED;
            PG8_STAGE(PG8_SB(0, 1), b2 + hstep, voffB);
            PG8_WAIT_V(6); PG8_BAR; PG8_MMA(1, 1, At, B1); PG8_BAR;
            PG8_LDB(B0, 1, 0); PG8_SCHED; PG8_LDA(At, 1, 0); PG8_STAGE(PG8_SA(0, 1), a2 + hstep, voffA);
            PG8_WAIT_L(8); PG8_BAR; PG8_WAIT_L(0); PG8_MMA(0, 0, At, B0); PG8_BAR; PG8_SCHED;
            PG8_LDB(B1, 1, 1); PG8_STAGE(PG8_SB(1, 0), b3, voffB);
            PG8_BAR; PG8_WAIT_L(0); PG8_MMA(0, 1, At, B1); PG8_BAR;
            PG8_LDA(At, 1, 1); PG8_STAGE(PG8_SA(1, 0), a3, voffA);
            PG8_BAR; PG8_WAIT_L(0); PG8_MMA(1, 0, At, B0); PG8_BAR; PG8_SCHED;
            PG8_STAGE(PG8_SB(1, 1), b3 + hstep, voffB);
            PG8_WAIT_V(6); PG8_BAR; PG8_MMA(1, 1, At, B1); PG8_BAR;
        }
        E(acc, cur, wr, wc, fr, fq);
        if (!has_next) break;
#pragma unroll
        for (int a = 0; a < 2; ++a)
#pragma unroll
            for (int b = 0; b < 2; ++b)
#pragma unroll
                for (int m = 0; m < 4; ++m)
#pragma unroll
                    for (int n = 0; n < 2; ++n) acc[a][b][m][n] = (f32x4){0.f, 0.f, 0.f, 0.f};
        cur = nxt; cA = nA; cB = nB; ++ui;
    }
    PG8_WAIT_V(0);
    if (wr == 0) PG8_BAR;
    PG8_BAR;
#undef PG8_SA
#undef PG8_SB
#undef PG8_STAGE
#undef PG8_LDA
#undef PG8_LDB
#undef PG8_MMA
#undef PG8_WAIT_V
#undef PG8_WAIT_L
#undef PG8_BAR
#undef PG8_SCHED
}
}

namespace att {
constexpr int D = 128, NW = 8, QBLK = 32, KVBLK = 64;
constexpr float THR = 8.f;
#ifndef ATT_SDEPTH
#define ATT_SDEPTH 1
#endif
constexpr size_t SHM_V = KVBLK * D * 2, SHM_K = KVBLK * D * 2, SHM_ATTN = 2 * SHM_V + 2 * SHM_K + NW * 64 * 4;
#define KSWZ(row, colB) ((row) * 256 + ((colB) ^ (((row) & 7) << 4)))
#define SBAR() __builtin_amdgcn_sched_barrier(0)
__device__ __forceinline__ int crow(int r, int hi) { return (r & 3) + 8 * (r >> 2) + 4 * hi; }
__device__ __forceinline__ void partialSM(f32x16& p0, f32x16& p1, float& m_reg, float& mn, float& alpha) {
    constexpr float C = SCALE * 1.4426950408889634f;
    float pmax = p0[0];
#pragma unroll
    for (int r = 1; r < 16; ++r) pmax = fmaxf(pmax, p0[r]);
#pragma unroll
    for (int r = 0; r < 16; ++r) pmax = fmaxf(pmax, p1[r]);
    { auto rr = __builtin_amdgcn_permlane32_swap(__float_as_uint(pmax), __float_as_uint(pmax), false, false);
      pmax = fmaxf(__uint_as_float(rr[0]), __uint_as_float(rr[1])); }
    if (__builtin_expect(__all(pmax - m_reg <= THR / SCALE), 1)) { mn = m_reg; alpha = 1.f; }
    else { mn = fmaxf(m_reg, pmax); alpha = __builtin_amdgcn_exp2f((m_reg - mn) * C); m_reg = mn; }
    float mnC = -mn * C;
#pragma unroll
    for (int r = 0; r < 16; ++r) p0[r] = fmaf(p0[r], C, mnC);
#pragma unroll
    for (int r = 0; r < 16; ++r) p1[r] = fmaf(p1[r], C, mnC);
#pragma unroll
    for (int r = 0; r < 16; ++r) p0[r] = __builtin_amdgcn_exp2f(p0[r]);
}
__device__ __forceinline__ void finishSM(f32x16& p0, f32x16& p1, float alpha, float& l_reg, bf16x8& pa0, bf16x8& pa1, bf16x8& pa2, bf16x8& pa3) {
#pragma unroll
    for (int r = 0; r < 16; ++r) p1[r] = __builtin_amdgcn_exp2f(p1[r]);
    float ps = 0;
#pragma unroll
    for (int r = 0; r < 16; ++r) ps += p0[r];
#pragma unroll
    for (int r = 0; r < 16; ++r) ps += p1[r];
    { auto rr = __builtin_amdgcn_permlane32_swap(__float_as_uint(ps), __float_as_uint(ps), false, false);
      ps = __uint_as_float(rr[0]) + __uint_as_float(rr[1]); }
    l_reg = l_reg * alpha + ps;
#define PK4(P, BASE, OUT) do { unsigned a0 = cvt_pk(P[BASE + 0], P[BASE + 1]), a1 = cvt_pk(P[BASE + 2], P[BASE + 3]);   \
    unsigned b0 = cvt_pk(P[BASE + 4], P[BASE + 5]), b1 = cvt_pk(P[BASE + 6], P[BASE + 7]);                              \
    auto r0 = __builtin_amdgcn_permlane32_swap(a0, b0, false, false); auto r1 = __builtin_amdgcn_permlane32_swap(a1, b1, false, false); \
    u32x4 w = {r0[0], r1[0], r0[1], r1[1]}; OUT = *reinterpret_cast<bf16x8*>(&w); } while (0)
    PK4(p0, 0, pa0); PK4(p0, 8, pa1); PK4(p1, 0, pa2); PK4(p1, 8, pa3);
#undef PK4
}
__device__ __forceinline__ void qkt(f32x16& p0, f32x16& p1, const bf16_t* Ks, const bf16x8* qr, int r32, int hi) {
    p0 = f32x16{}; p1 = f32x16{};
#pragma unroll
    for (int d0 = 0; d0 < 8; ++d0) { int cb = (d0 * 16 + hi * 8) * 2;
        bf16x8 b0 = *reinterpret_cast<const bf16x8*>((const char*)Ks + KSWZ(r32, cb));
        bf16x8 b1 = *reinterpret_cast<const bf16x8*>((const char*)Ks + KSWZ(32 + r32, cb));
        p0 = __builtin_amdgcn_mfma_f32_32x32x16_bf16(b0, qr[d0], p0, 0, 0, 0);
        p1 = __builtin_amdgcn_mfma_f32_32x32x16_bf16(b1, qr[d0], p1, 0, 0, 0); }
}
template <bool BAND> __device__ __forceinline__ void maskp(f32x16& p0, f32x16& p1, int t, int nct, int qp, int hi) {
    if constexpr (BAND) {
        if (t >= nct) {
            const int kb = (t - nct) * 64;
#pragma unroll
            for (int r = 0; r < 16; ++r) { const int kp = kb + crow(r, hi); int dd = qp - kp; dd = dd < 0 ? -dd : dd; if (dd > 128) p0[r] = -1e30f;
                int d2 = qp - kp - 32; d2 = d2 < 0 ? -d2 : d2; if (d2 > 128) p1[r] = -1e30f; }
        }
    }
}
__device__ __forceinline__ int v_st(int k, int c) { const int kk = (k & ~0xC) | ((k & 4) << 1) | ((k & 8) >> 1); return ((kk >> 3) * 4 + (c >> 5)) * 512 + ((kk & 7) * 32 + (c & 31)) * 2; }
__device__ __forceinline__ int v_rd_base(int lane) { return ((lane & 3) << 3) | (((lane >> 2) & 3) << 6) | (((lane >> 4) & 1) << 5) | (((lane >> 5) & 1) << 8); }
constexpr int v_rd_off(int d0, int ks, int half) { return d0 * 512 + ks * 4096 + half * 2048; }
template <int OFF> __device__ __forceinline__ s16x4 tr_read(int vb) {
    s16x4 r; asm volatile("ds_read_b64_tr_b16 %0, %1 offset:%2" : "=&v"(r) : "v"(vb), "i"(OFF) : "memory"); return r;
}
template <int D0> __device__ __forceinline__ void pv_one(f32x16& od, int vb, bf16x8 pa0, bf16x8 pa1, bf16x8 pa2, bf16x8 pa3) {
    const s16x4 l0 = tr_read<v_rd_off(D0, 0, 0)>(vb), h0 = tr_read<v_rd_off(D0, 0, 1)>(vb), l1 = tr_read<v_rd_off(D0, 1, 0)>(vb), h1 = tr_read<v_rd_off(D0, 1, 1)>(vb);
    const s16x4 l2 = tr_read<v_rd_off(D0, 2, 0)>(vb), h2 = tr_read<v_rd_off(D0, 2, 1)>(vb), l3 = tr_read<v_rd_off(D0, 3, 0)>(vb), h3 = tr_read<v_rd_off(D0, 3, 1)>(vb);
    asm volatile("s_waitcnt lgkmcnt(0)" ::: "memory"); SBAR();
#define PK(L, H) (bf16x8){L[0], L[1], L[2], L[3], H[0], H[1], H[2], H[3]}
    od = __builtin_amdgcn_mfma_f32_32x32x16_bf16(pa0, PK(l0, h0), od, 0, 0, 0);
    od = __builtin_amdgcn_mfma_f32_32x32x16_bf16(pa1, PK(l1, h1), od, 0, 0, 0);
    od = __builtin_amdgcn_mfma_f32_32x32x16_bf16(pa2, PK(l2, h2), od, 0, 0, 0);
    od = __builtin_amdgcn_mfma_f32_32x32x16_bf16(pa3, PK(l3, h3), od, 0, 0, 0);
#undef PK
}
__device__ __forceinline__ void pv_d0(f32x16* o, int vb, bf16x8 pa0, bf16x8 pa1, bf16x8 pa2, bf16x8 pa3) {
    pv_one<0>(o[0], vb, pa0, pa1, pa2, pa3); pv_one<1>(o[1], vb, pa0, pa1, pa2, pa3); pv_one<2>(o[2], vb, pa0, pa1, pa2, pa3); pv_one<3>(o[3], vb, pa0, pa1, pa2, pa3);
}

template <bool BAND>
__device__ __forceinline__ void attn_body(const bf16_t* __restrict__ Qb, int ldq, const bf16_t* __restrict__ Kc, const bf16_t* __restrict__ Vc, int ldc, int nct,
                                          const bf16_t* __restrict__ Kl, const bf16_t* __restrict__ Vl, int ldl, int NT,
                                          bf16_t* __restrict__ Ob, int ldo, float m_init, float l_init, int qoff, char* lds) {
    int tid = threadIdx.x; asm volatile("" : "+v"(tid));
    const int wid = tid >> 6, lane = tid & 63, r32 = lane & 31, hi = lane >> 5;
    bf16_t* V_lds = (bf16_t*)lds; bf16_t* K_lds = (bf16_t*)(lds + 2 * SHM_V);
    float* wsl = (float*)(lds + 2 * SHM_V + 2 * SHM_K) + wid * 64; float* li_l = wsl; float* al_l = wsl + 32;
    float m_reg = m_init, l_reg = l_init; f32x16 o[4] = {}; bf16x8 qr[8];
    const bf16_t* Qw = Qb + (long)(wid * QBLK + r32) * ldq + hi * 8;
#pragma unroll
    for (int d0 = 0; d0 < 8; ++d0) qr[d0] = *reinterpret_cast<const bf16x8*>(Qw + d0 * 16);
    const int sr = tid >> 4, sc = (tid & 15) * 8, vst0 = v_st(sr, sc), vst1 = v_st(32 + sr, sc);
    const int vb0 = (int)(uintptr_t)V_lds + v_rd_base(lane);
    const int qp = qoff + wid * QBLK + r32;
    const int offc = sr * ldc + sc, offl = sr * ldl + sc;
    constexpr int SDEPTH = ATT_SDEPTH;
    struct { bf16x8 vs0, vs1, ks0, ks1; } sr_[SDEPTH];
#define SLOAD(i, t) do { const bool _c = (t) < nct; const bf16_t* _k = _c ? Kc + (long)(t) * 64 * ldc : Kl + (long)((t) - nct) * 64 * ldl; \
    const bf16_t* _v = _c ? Vc + (long)(t) * 64 * ldc : Vl + (long)((t) - nct) * 64 * ldl; const int _o = _c ? offc : offl; const int _h = (_c ? ldc : ldl) * 32; \
    sr_[i].vs0 = *reinterpret_cast<const bf16x8*>(_v + _o); sr_[i].vs1 = *reinterpret_cast<const bf16x8*>(_v + _o + _h); \
    sr_[i].ks0 = *reinterpret_cast<const bf16x8*>(_k + _o); sr_[i].ks1 = *reinterpret_cast<const bf16x8*>(_k + _o + _h); } while (0)
#define SWRITE(b, i) do { *(bf16x8*)((char*)V_lds + (b) * SHM_V + vst0) = sr_[i].vs0;          \
    *(bf16x8*)((char*)V_lds + (b) * SHM_V + vst1) = sr_[i].vs1; int kc = sc * 2;               \
    *(bf16x8*)((char*)K_lds + (b) * SHM_K + KSWZ(sr, kc)) = sr_[i].ks0;                       \
    *(bf16x8*)((char*)K_lds + (b) * SHM_K + KSWZ(32 + sr, kc)) = sr_[i].ks1; } while (0)
#define SWAIT() do { if constexpr (SDEPTH == 2) asm volatile("s_waitcnt vmcnt(4)" ::: "memory"); else asm volatile("s_waitcnt vmcnt(0)" ::: "memory"); } while (0)
#define RESC(a) do { if (__any((a) < 1.f)) { if (hi == 0) al_l[r32] = (a); asm volatile("s_waitcnt lgkmcnt(0)" ::: "memory"); \
    _Pragma("unroll") for (int d = 0; d < 4; ++d) _Pragma("unroll") for (int r = 0; r < 16; ++r) o[d][r] *= al_l[crow(r, hi)]; } } while (0)
    f32x16 pA0, pA1, pB0, pB1; float mnA, mnB, alA, alB; bf16x8 pa0, pa1, pa2, pa3;
    constexpr int SE = 0, SO = SDEPTH - 1;
    SLOAD(SE, 0); asm volatile("s_waitcnt vmcnt(0)" ::: "memory"); SWRITE(0, SE); __syncthreads();
    qkt(pA0, pA1, K_lds, qr, r32, hi); maskp<BAND>(pA0, pA1, 0, nct, qp, hi); partialSM(pA0, pA1, m_reg, mnA, alA);
    SLOAD(SO, 1); if constexpr (SDEPTH == 2) { if (2 < NT) SLOAD(SE, 2); }
    SWAIT(); SWRITE(1, SO); __syncthreads();
    for (int j = 1; j + 1 < NT; j += 2) {
        SBAR(); qkt(pB0, pB1, (bf16_t*)((char*)K_lds + SHM_K), qr, r32, hi); maskp<BAND>(pB0, pB1, j, nct, qp, hi);
        finishSM(pA0, pA1, alA, l_reg, pa0, pa1, pa2, pa3); SBAR();
        SLOAD(SO, j + SDEPTH); SBAR();
        pv_d0(o, vb0, pa0, pa1, pa2, pa3); partialSM(pB0, pB1, m_reg, mnB, alB);
        __syncthreads(); SWAIT(); SWRITE(0, SE);
        RESC(alB); __syncthreads();
        SBAR(); qkt(pA0, pA1, K_lds, qr, r32, hi); maskp<BAND>(pA0, pA1, j + 1, nct, qp, hi);
        finishSM(pB0, pB1, alB, l_reg, pa0, pa1, pa2, pa3); SBAR();
        if (SDEPTH == 1 || j + 3 < NT) SLOAD(SE, j + 1 + SDEPTH); SBAR();
        pv_d0(o, vb0 + (int)SHM_V, pa0, pa1, pa2, pa3); partialSM(pA0, pA1, m_reg, mnA, alA);
        __syncthreads(); SWAIT(); SWRITE(1, SO);
        RESC(alA); __syncthreads();
    }
    SBAR(); qkt(pB0, pB1, (bf16_t*)((char*)K_lds + SHM_K), qr, r32, hi); maskp<BAND>(pB0, pB1, NT - 1, nct, qp, hi);
    finishSM(pA0, pA1, alA, l_reg, pa0, pa1, pa2, pa3); SBAR();
    pv_d0(o, vb0, pa0, pa1, pa2, pa3); partialSM(pB0, pB1, m_reg, mnB, alB);
    __syncthreads(); RESC(alB);
    finishSM(pB0, pB1, alB, l_reg, pa0, pa1, pa2, pa3); SBAR();
    pv_d0(o, vb0 + (int)SHM_V, pa0, pa1, pa2, pa3);
    if (hi == 0) li_l[r32] = l_reg; asm volatile("s_waitcnt lgkmcnt(0)" ::: "memory");
    float rli[16];
#pragma unroll
    for (int r = 0; r < 16; ++r) rli[r] = __builtin_amdgcn_rcpf(li_l[crow(r, hi)]);
    bf16_t* Ow = Ob + (long)(wid * QBLK) * ldo;
#pragma unroll
    for (int r = 0; r < 16; ++r) { int orow = crow(r, hi);
#pragma unroll
        for (int d0 = 0; d0 < 4; ++d0) Ow[(long)orow * ldo + d0 * 32 + r32] = (bf16_t)f2bf(o[d0][r] * rli[r]); }
    __syncthreads();
#undef SLOAD
#undef SWRITE
#undef SWAIT
#undef RESC
}
}

struct Params {
    const float *x_prompt, *x_sample, *state_a, *cache_b, *cache_c, *c, *c_ctx, *ada_w, *ada_b, *norm1_g, *norm2_g, *final_g,
                *mlp_w1, *mlp_w2, *ev_w_in, *a_conv, *a_log, *a_dt_bias, *a_norm_g, *b_sink, *ev_w_out, *od_w_in, *c_qnorm_g, *c_knorm_g, *od_w_out;
    float* out; unsigned char* ws;
};

template <int MAP>
__device__ __forceinline__ void transpose_item(const float* W, int K, int Nsrc, bf16_t* WT, int nblk, LAS float* scr, int item, int lane) {
    const int kb = item / nblk, nb = item % nblk, k0 = 64 * kb, n0 = 32 * nb;
    const int nd = n0 + (lane & 31);
    int src = nd;
    if (MAP == 1) src = nd < 2048 ? nd : (nd < 3072 ? nd + 16 : (nd < 3088 ? nd - 1024 : -1));
    float tv[32];
#pragma unroll
    for (int i = 0; i < 32; ++i) { const int kk = 2 * i + (lane >> 5); const float wv_ = W[(size_t)(k0 + kk) * Nsrc + (src >= 0 ? src : 0)]; tv[i] = src >= 0 ? wv_ : 0.f; }
#pragma unroll
    for (int i = 0; i < 32; ++i) { const int kk = 2 * i + (lane >> 5); scr[kk * 33 + (lane & 31)] = tv[i]; }
    LDS_WAIT();
    const int c = lane & 7;
#pragma unroll
    for (int j = 0; j < 4; ++j) { const int n = (lane >> 3) + 8 * j; const LAS float* s = scr + (8 * c) * 33 + n;
        u32x4 o; o.x = cvt_pk(s[0 * 33], s[1 * 33]); o.y = cvt_pk(s[2 * 33], s[3 * 33]); o.z = cvt_pk(s[4 * 33], s[5 * 33]); o.w = cvt_pk(s[6 * 33], s[7 * 33]);
        *(u32x4*)(WT + (size_t)(n0 + n) * K + k0 + 8 * c) = o; }
    LDS_WAIT();
}

__device__ __forceinline__ void phase0(const Params& p, unsigned char* lds_raw, int tid, int lane, int wave, int bid, int G) {
    asm volatile("" : "+s"(bid), "+s"(G), "+s"(wave));
    size_t zo_ = 0; asm volatile("" : "+s"(zo_)); unsigned char* ws_ = p.ws + zo_;
    asm volatile("" : "+v"(tid), "+v"(lane));
    LAS unsigned char* lds = (LAS unsigned char*)lds_raw;
    LAS float* SIL = (LAS float*)(lds + 73728);
    LAS float* RED = (LAS float*)(lds + 94208);
    for (int i = tid; i < 5 * 1024; i += 512) { const int c = i >> 10, k = i & 1023; const float v = c == 0 ? p.c_ctx[k] : p.c[(c - 1) * 1024 + k]; SIL[i] = silu_f(v); }
    __syncthreads();
    float* MOD = (float*)(ws_ + WS_MOD);
    for (int it = bid; it < 768; it += G) {
        const int l = it / 192, cgp = it % 192;
        const int col = lane & 31, kh = lane >> 5;
        const float* w = p.ada_w + (size_t)l * 1024 * 6144 + cgp * 32 + col;
        float a0 = 0.f, a1 = 0.f, a2 = 0.f, a3 = 0.f, a4 = 0.f;
        const int kb = wave * 128 + kh;
#pragma unroll 32
        for (int k2 = 0; k2 < 64; ++k2) { const int k = kb + 2 * k2; const float wv = w[(size_t)k * 6144];
            a0 += SIL[k] * wv; a1 += SIL[1024 + k] * wv; a2 += SIL[2048 + k] * wv; a3 += SIL[3072 + k] * wv; a4 += SIL[4096 + k] * wv; }
        a0 += __shfl_xor(a0, 32); a1 += __shfl_xor(a1, 32); a2 += __shfl_xor(a2, 32); a3 += __shfl_xor(a3, 32); a4 += __shfl_xor(a4, 32);
        if (kh == 0) { RED[(wave * 5 + 0) * 32 + col] = a0; RED[(wave * 5 + 1) * 32 + col] = a1; RED[(wave * 5 + 2) * 32 + col] = a2; RED[(wave * 5 + 3) * 32 + col] = a3; RED[(wave * 5 + 4) * 32 + col] = a4; }
        __syncthreads();
        if (tid < 160) { const int c = tid >> 5, cc = tid & 31; float sacc = 0.f;
#pragma unroll
            for (int w8 = 0; w8 < 8; ++w8) sacc += RED[(w8 * 5 + c) * 32 + cc];
            MOD[(l * 5 + c) * 6144 + cgp * 32 + cc] = sacc + p.ada_b[l * 6144 + cgp * 32 + cc]; }
        __syncthreads();
    }
    LAS float* scr = (LAS float*)(lds + wave * 9216);
    const int gw = bid * 8 + wave, NGW = G * 8;
    constexpr int I_EVIN = 16 * 104, I_SQ = 16 * 32, I_ODIN = 16 * 48, I_W1 = 16 * 128, I_W2 = 64 * 32;
    constexpr int NITEMS = 2 * I_EVIN + 2 * I_SQ + 2 * I_ODIN + 2 * I_SQ + 4 * I_W1 + 4 * I_W2;
    for (int it = gw; it < NITEMS; it += NGW) {
        int r = it;
        if (r < 2 * I_EVIN) { const int i = r / I_EVIN; transpose_item<1>(p.ev_w_in + (size_t)i * 1024 * 3088, 1024, 3088, (bf16_t*)(ws_ + WS_WEVIN) + (size_t)i * EVN * 1024, 104, scr, r % I_EVIN, lane); continue; } r -= 2 * I_EVIN;
        if (r < 2 * I_SQ) { const int i = r / I_SQ; transpose_item<0>(p.ev_w_out + (size_t)i * 1024 * 1024, 1024, 1024, (bf16_t*)(ws_ + WS_WEVOUT) + (size_t)i * 1024 * 1024, 32, scr, r % I_SQ, lane); continue; } r -= 2 * I_SQ;
        if (r < 2 * I_ODIN) { const int i = r / I_ODIN; transpose_item<0>(p.od_w_in + (size_t)i * 1024 * 1536, 1024, 1536, (bf16_t*)(ws_ + WS_WODIN) + (size_t)i * 1536 * 1024, 48, scr, r % I_ODIN, lane); continue; } r -= 2 * I_ODIN;
        if (r < 2 * I_SQ) { const int i = r / I_SQ; transpose_item<0>(p.od_w_out + (size_t)i * 1024 * 1024, 1024, 1024, (bf16_t*)(ws_ + WS_WODOUT) + (size_t)i * 1024 * 1024, 32, scr, r % I_SQ, lane); continue; } r -= 2 * I_SQ;
        if (r < 4 * I_W1) { const int i = r / I_W1; transpose_item<0>(p.mlp_w1 + (size_t)i * 1024 * 4096, 1024, 4096, (bf16_t*)(ws_ + WS_W1) + (size_t)i * 4096 * 1024, 128, scr, r % I_W1, lane); continue; } r -= 4 * I_W1;
        { const int i = r / I_W2; transpose_item<0>(p.mlp_w2 + (size_t)i * 4096 * 1024, 4096, 1024, (bf16_t*)(ws_ + WS_W2) + (size_t)i * 1024 * 4096, 32, scr, r % I_W2, lane); }
    }
    const int NC8 = 262144;
    for (int i = bid * 512 + tid; i < 2 * NC8; i += G * 512) {
        const bool isb = i < NC8; const int j = isb ? i : i - NC8;
        const float* s = (isb ? p.cache_b : p.cache_c) + (size_t)j * 8;
        const f32x4 a = *(const f32x4*)s, b = *(const f32x4*)(s + 4);
        u32x4 o; o.x = cvt_pk(a[0], a[1]); o.y = cvt_pk(a[2], a[3]); o.z = cvt_pk(b[0], b[1]); o.w = cvt_pk(b[2], b[3]);
        *(u32x4*)((bf16_t*)(ws_ + (isb ? WS_CTXB : WS_CTXC)) + (size_t)j * 8) = o;
    }
}

__device__ __forceinline__ void norm_phase(const float* xp, const float* xs, float* Xcopy, const float* g, const float* modl, int shift_chunk, int scale_chunk,
                                           bf16_t* H, int gw, int NGW, int lane) {
    asm volatile("" : "+s"(gw), "+s"(NGW));
    asm volatile("" : "+v"(lane));
    for (int m = gw; m < NTOK; m += NGW) {
        const float* src = m < NPR ? xp + (size_t)m * DM : xs + (size_t)(m - NPR) * DM;
        const int cidx = m < NPR ? 0 : 1 + ((m - NPR) >> 11);
        const f32x4* xr = (const f32x4*)src + lane;
        f32x4 v[4]; float s = 0.f;
#pragma unroll
        for (int j = 0; j < 4; ++j) { v[j] = xr[64 * j]; s += (v[j].x * v[j].x + v[j].y * v[j].y) + (v[j].z * v[j].z + v[j].w * v[j].w); }
        const float rstd = rsqrtf(wave_sum(s) * (1.f / DM) + EPS);
        const f32x4* gp = (const f32x4*)g + lane;
        const f32x4* shp = (const f32x4*)(modl + cidx * 6144 + shift_chunk * 1024) + lane;
        const f32x4* scp = (const f32x4*)(modl + cidx * 6144 + scale_chunk * 1024) + lane;
        u32x2* o8 = (u32x2*)(H + (size_t)m * DM) + lane;
#pragma unroll
        for (int j = 0; j < 4; ++j) {
            const f32x4 gg = gp[64 * j], sh = shp[64 * j], sc = scp[64 * j];
            const f32x4 h = v[j] * rstd * gg * (sc + 1.f) + sh;
            u32x2 w; w.x = cvt_pk(h.x, h.y); w.y = cvt_pk(h.z, h.w); o8[64 * j] = w;
            if (Xcopy) ((f32x4*)(Xcopy + (size_t)m * DM) + lane)[64 * j] = v[j];
        }
    }
}
__device__ __forceinline__ void norm16_phase(const bf16_t* X16, const float* g, const float* modl, int shift_chunk, int scale_chunk, bf16_t* H, int gw, int NGW, int lane) {
    asm volatile("" : "+s"(gw), "+s"(NGW));
    asm volatile("" : "+v"(lane));
    for (int m = gw; m < NTOK; m += NGW) {
        const int cidx = m < NPR ? 0 : 1 + ((m - NPR) >> 11);
        const bf16_t* xr = X16 + (size_t)m * DM + lane * 8;
        const u32x4 r0 = *(const u32x4*)xr, r1 = *(const u32x4*)(xr + 512);
        float v[16];
        v[0] = bflo(r0.x); v[1] = bfhi(r0.x); v[2] = bflo(r0.y); v[3] = bfhi(r0.y); v[4] = bflo(r0.z); v[5] = bfhi(r0.z); v[6] = bflo(r0.w); v[7] = bfhi(r0.w);
        v[8] = bflo(r1.x); v[9] = bfhi(r1.x); v[10] = bflo(r1.y); v[11] = bfhi(r1.y); v[12] = bflo(r1.z); v[13] = bfhi(r1.z); v[14] = bflo(r1.w); v[15] = bfhi(r1.w);
        float sq = 0.f;
#pragma unroll
        for (int j = 0; j < 16; ++j) sq += v[j] * v[j];
        const float rstd = rsqrtf(wave_sum(sq) * (1.f / DM) + EPS);
        const float* gp = g + lane * 8; const float* shp = modl + cidx * 6144 + shift_chunk * 1024 + lane * 8; const float* scp = modl + cidx * 6144 + scale_chunk * 1024 + lane * 8;
        u32x4 o[2];
#pragma unroll
        for (int hh = 0; hh < 2; ++hh) {
            const f32x4 ga = *(const f32x4*)(gp + 512 * hh), gb = *(const f32x4*)(gp + 512 * hh + 4), sa = *(const f32x4*)(shp + 512 * hh), sb = *(const f32x4*)(shp + 512 * hh + 4);
            const f32x4 ca = *(const f32x4*)(scp + 512 * hh), cb = *(const f32x4*)(scp + 512 * hh + 4);
            float h8[8];
#pragma unroll
            for (int j = 0; j < 4; ++j) { h8[j] = v[8 * hh + j] * rstd * ga[j] * (ca[j] + 1.f) + sa[j]; h8[4 + j] = v[8 * hh + 4 + j] * rstd * gb[j] * (cb[j] + 1.f) + sb[j]; }
            o[hh].x = cvt_pk(h8[0], h8[1]); o[hh].y = cvt_pk(h8[2], h8[3]); o[hh].z = cvt_pk(h8[4], h8[5]); o[hh].w = cvt_pk(h8[6], h8[7]);
        }
        bf16_t* hr = H + (size_t)m * DM + lane * 8; *(u32x4*)hr = o[0]; *(u32x4*)(hr + 512) = o[1];
    }
}
__device__ __forceinline__ void final_phase(const bf16_t* X16, float* Y, const float* g, int gw, int NGW, int lane) {
    asm volatile("" : "+s"(gw), "+s"(NGW));
    asm volatile("" : "+v"(lane));
    for (int m = gw; m < NTOK; m += NGW) {
        const bf16_t* xr = X16 + (size_t)m * DM + lane * 8;
        const u32x4 r0 = *(const u32x4*)xr, r1 = *(const u32x4*)(xr + 512);
        float v[16];
        v[0] = bflo(r0.x); v[1] = bfhi(r0.x); v[2] = bflo(r0.y); v[3] = bfhi(r0.y); v[4] = bflo(r0.z); v[5] = bfhi(r0.z); v[6] = bflo(r0.w); v[7] = bfhi(r0.w);
        v[8] = bflo(r1.x); v[9] = bfhi(r1.x); v[10] = bflo(r1.y); v[11] = bfhi(r1.y); v[12] = bflo(r1.z); v[13] = bfhi(r1.z); v[14] = bflo(r1.w); v[15] = bfhi(r1.w);
        float sq = 0.f;
#pragma unroll
        for (int j = 0; j < 16; ++j) sq += v[j] * v[j];
        const float rstd = rsqrtf(wave_sum(sq) * (1.f / DM) + EPS);
        float* yr = Y + (size_t)m * DM + lane * 8;
#pragma unroll
        for (int hh = 0; hh < 2; ++hh) { const f32x4 ga = *(const f32x4*)(g + lane * 8 + 512 * hh), gb = *(const f32x4*)(g + lane * 8 + 512 * hh + 4);
            *(f32x4*)(yr + 512 * hh) = (f32x4){v[8 * hh] * rstd * ga[0], v[8 * hh + 1] * rstd * ga[1], v[8 * hh + 2] * rstd * ga[2], v[8 * hh + 3] * rstd * ga[3]};
            *(f32x4*)(yr + 512 * hh + 4) = (f32x4){v[8 * hh + 4] * rstd * gb[0], v[8 * hh + 5] * rstd * gb[1], v[8 * hh + 6] * rstd * gb[2], v[8 * hh + 7] * rstd * gb[3]}; }
    }
}

__device__ __forceinline__ void e3a_phase(const Params& p, int i, unsigned char* lds_raw, int tid, int lane, int wave, int bid, int G) {
    asm volatile("" : "+s"(bid), "+s"(G), "+s"(wave));
    size_t zo_ = 0; asm volatile("" : "+s"(zo_)); unsigned char* ws_ = p.ws + zo_;
    asm volatile("" : "+v"(tid), "+v"(lane));
    const bf16_t* PROJ = (const bf16_t*)(ws_ + WS_D);
    bf16_t* QN = (bf16_t*)(ws_ + WS_QN); bf16_t* KN = (bf16_t*)(ws_ + WS_KN); bf16_t* VN = (bf16_t*)(ws_ + WS_VN); bf16_t* KNT = (bf16_t*)(ws_ + WS_KNT);
    const float* BG = (const float*)(ws_ + WS_BG); float* BETA = (float*)(ws_ + WS_BETA); float* GG = (float*)(ws_ + WS_G);
    LAS float* QF = (LAS float*)lds_raw;
    LAS float* KF = QF + 64 * 132;
    const float* convw = p.a_conv + (size_t)i * 3 * 1536;
    for (int it = bid; it < 768; it += G) {
        const int tb = it >> 2, h = it & 3, m0 = tb * 64;
        const bool first = tb < 64 ? ((tb & 3) == 0) : (((tb - 64) & 31) == 0);
        const bool lastb = tb < 64 ? ((tb & 3) == 3) : (((tb - 64) & 31) == 31);
        const int d = tid & 127, rg = tid >> 7, c0 = rg * 16;
#pragma unroll
        for (int part = 0; part < 3; ++part) {
            const int col = part * 512 + h * 128 + d;
            const float w0 = convw[col], w1 = convw[1536 + col], w2 = convw[3072 + col];
            const bf16_t* src = PROJ + (size_t)m0 * EVLD + col;
            const bool zp = (c0 == 0 && first);
            const float xp_ld = bf2f(src[(long)(zp ? c0 : c0 - 1) * EVLD]);
            float xprev = zp ? 0.f : xp_ld;
            float xcur = bf2f(src[(long)c0 * EVLD]);
            float vy[16];
#pragma unroll
            for (int cc = 0; cc < 16; ++cc) {
                const int c = c0 + cc;
                const bool zn = (c == 63 && lastb);
                const float xn_ld = bf2f(src[(long)(zn ? c : c + 1) * EVLD]);
                const float xnext = zn ? 0.f : xn_ld;
                const float y = silu_f(w0 * xprev + w1 * xcur + w2 * xnext);
                if (part == 0) QF[c * 132 + d] = y; else if (part == 1) KF[c * 132 + d] = y; else vy[cc] = y;
                xprev = xcur; xcur = xnext;
            }
            if (part == 2) {
                u32x4 a, b;
                a.x = cvt_pk(vy[0], vy[1]); a.y = cvt_pk(vy[2], vy[3]); a.z = cvt_pk(vy[4], vy[5]); a.w = cvt_pk(vy[6], vy[7]);
                b.x = cvt_pk(vy[8], vy[9]); b.y = cvt_pk(vy[10], vy[11]); b.z = cvt_pk(vy[12], vy[13]); b.w = cvt_pk(vy[14], vy[15]);
                bf16_t* dv = VN + ((size_t)(tb * 4 + h) * 128 + d) * 64 + c0; *(u32x4*)dv = a; *(u32x4*)(dv + 8) = b;
            }
        }
        __syncthreads();
        {
            const int row = tid >> 3, seg = tid & 7;
            LAS float* qp = QF + row * 132 + seg * 16; LAS float* kp = KF + row * 132 + seg * 16;
            float qv[16], kv[16]; float sq = 0.f, sk = 0.f;
#pragma unroll
            for (int j = 0; j < 16; ++j) { qv[j] = qp[j]; kv[j] = kp[j]; sq += qv[j] * qv[j]; sk += kv[j] * kv[j]; }
            sq += __shfl_xor(sq, 1); sq += __shfl_xor(sq, 2); sq += __shfl_xor(sq, 4);
            sk += __shfl_xor(sk, 1); sk += __shfl_xor(sk, 2); sk += __shfl_xor(sk, 4);
            const float rq = rsqrtf(sq + EPS) * SCALE, rk = rsqrtf(sk + EPS);
            u32x4 a, b;
            a.x = cvt_pk(qv[0] * rq, qv[1] * rq); a.y = cvt_pk(qv[2] * rq, qv[3] * rq); a.z = cvt_pk(qv[4] * rq, qv[5] * rq); a.w = cvt_pk(qv[6] * rq, qv[7] * rq);
            b.x = cvt_pk(qv[8] * rq, qv[9] * rq); b.y = cvt_pk(qv[10] * rq, qv[11] * rq); b.z = cvt_pk(qv[12] * rq, qv[13] * rq); b.w = cvt_pk(qv[14] * rq, qv[15] * rq);
            bf16_t* qd = QN + (size_t)(m0 + row) * 512 + h * 128 + seg * 16; *(u32x4*)qd = a; *(u32x4*)(qd + 8) = b;
#pragma unroll
            for (int j = 0; j < 16; ++j) kv[j] *= rk;
            a.x = cvt_pk(kv[0], kv[1]); a.y = cvt_pk(kv[2], kv[3]); a.z = cvt_pk(kv[4], kv[5]); a.w = cvt_pk(kv[6], kv[7]);
            b.x = cvt_pk(kv[8], kv[9]); b.y = cvt_pk(kv[10], kv[11]); b.z = cvt_pk(kv[12], kv[13]); b.w = cvt_pk(kv[14], kv[15]);
            bf16_t* kd = KN + (size_t)(m0 + row) * 512 + h * 128 + seg * 16; *(u32x4*)kd = a; *(u32x4*)(kd + 8) = b;
#pragma unroll
            for (int j = 0; j < 16; ++j) kp[j] = kv[j];
        }
        if (tid < 128) {
            const int c = tid & 63, dir = tid >> 6, m = m0 + c;
            const float bv = BG[(size_t)m * 16 + dir * 4 + h];
            const float al = BG[(size_t)m * 16 + 8 + dir * 4 + h] + p.a_dt_bias[i * 8 + dir * 4 + h];
            const float sp = al > 20.f ? al : log1pf(__expf(al));
            BETA[(size_t)(dir * 4 + h) * NTOK + m] = 1.f / (1.f + __expf(-bv));
            GG[(size_t)(dir * 4 + h) * NTOK + m] = -__expf(p.a_log[i * 8 + dir * 4 + h]) * sp;
        }
        __syncthreads();
        {
            u32x4 a, b; LAS float* kc = KF + (c0) * 132 + d;
            a.x = cvt_pk(kc[0 * 132], kc[1 * 132]); a.y = cvt_pk(kc[2 * 132], kc[3 * 132]); a.z = cvt_pk(kc[4 * 132], kc[5 * 132]); a.w = cvt_pk(kc[6 * 132], kc[7 * 132]);
            b.x = cvt_pk(kc[8 * 132], kc[9 * 132]); b.y = cvt_pk(kc[10 * 132], kc[11 * 132]); b.z = cvt_pk(kc[12 * 132], kc[13 * 132]); b.w = cvt_pk(kc[14 * 132], kc[15 * 132]);
            bf16_t* dst = KNT + ((size_t)(tb * 4 + h) * 128 + d) * 64 + c0; *(u32x4*)dst = a; *(u32x4*)(dst + 8) = b;
        }
        __syncthreads();
    }
    bf16_t* PW = (bf16_t*)(ws_ + WS_D);
    const int gw = bid * 8 + wave, NGW = G * 8;
    const int axis = lane >> 5, f = lane & 31;
    const float inv = exp2f(-(float)f * (13.287712379549449f / 32.f));
    for (int m = NPR + gw; m < NTOK; m += NGW) {
        const int t = (m - NPR) & 2047; const float pos = (float)(axis ? (t & 63) : (t >> 6));
        const float ang = pos * inv, cs = __cosf(ang), sn = __sinf(ang);
        bf16_t* base = PW + (size_t)m * EVLD + 2048 + axis * 64 + f;
#pragma unroll
        for (int hh = 0; hh < 6; ++hh) { bf16_t* q = base + hh * 128; const float x1 = bf2f(q[0]), x2 = bf2f(q[32]);
            q[0] = (bf16_t)f2bf(x1 * cs - x2 * sn); q[32] = (bf16_t)f2bf(x2 * cs + x1 * sn); }
    }
}

__device__ __forceinline__ void e3b_phase(const Params& p, unsigned char* lds_raw, int tid, int lane, int wave, int bid, int G) {
    asm volatile("" : "+s"(bid), "+s"(G), "+s"(wave));
    asm volatile("" : "+v"(tid), "+v"(lane));
    size_t zo_ = 0; asm volatile("" : "+s"(zo_)); unsigned char* ws_ = p.ws + zo_;
    const bf16_t* QN = (const bf16_t*)(ws_ + WS_QN); const bf16_t* KN = (const bf16_t*)(ws_ + WS_KN); const bf16_t* VN = (const bf16_t*)(ws_ + WS_VN);
    const float* BETA = (const float*)(ws_ + WS_BETA); const float* GG = (const float*)(ws_ + WS_G); float* GC = (float*)(ws_ + WS_GC);
    bf16_t* U = (bf16_t*)(ws_ + WS_U); bf16_t* Wb = (bf16_t*)(ws_ + WS_W); bf16_t* QK = (bf16_t*)(ws_ + WS_QK);
    const int half = wave >> 2, hw = wave & 3, ht = tid & 255;
    LAS unsigned char* lds = (LAS unsigned char*)lds_raw + half * 62464;
    const bf16_t* KNT = (const bf16_t*)(ws_ + WS_KNT);
    LAS bf16_t* KB = (LAS bf16_t*)lds;
    LAS bf16_t* QB = (LAS bf16_t*)(lds + 17408);
    LAS float* Af = (LAS float*)(lds + 34816);
    LAS float* gcl = (LAS float*)(lds + 52224);
    LAS float* betal = gcl + 64;
    u32x4 kreg[4], qreg[4];
#define E3B_LOAD(pp) do { const int it_ = 2 * (pp) + half; const int dir_ = it_ & 1, h_ = (it_ >> 1) & 3, m0_ = (it_ >> 3) * 64; \
    _Pragma("unroll") for (int j_ = 0; j_ < 4; ++j_) { const int id_ = ht + 256 * j_, c_ = id_ >> 4, seg_ = id_ & 15, tau_ = dir_ ? 63 - c_ : c_; \
        kreg[j_] = *(const u32x4*)(KN + (size_t)(m0_ + tau_) * 512 + h_ * 128 + seg_ * 8); \
        qreg[j_] = *(const u32x4*)(QN + (size_t)(m0_ + tau_) * 512 + h_ * 128 + seg_ * 8); } } while (0)
    if (bid < 768) E3B_LOAD(bid);
    for (int pit = bid; pit < 768; pit += G) {
        const int it = 2 * pit + half;
        const int dir = it & 1, h = (it >> 1) & 3, tb = it >> 3, m0 = tb * 64;
#pragma unroll
        for (int j = 0; j < 4; ++j) { const int id = ht + 256 * j, c = id >> 4, seg = id & 15;
            *(LAS u32x4*)(KB + c * 136 + seg * 8) = kreg[j];
            *(LAS u32x4*)(QB + c * 136 + seg * 8) = qreg[j]; }
        const int fr5 = lane & 15, fq5 = lane >> 4;
        const bf16_t* vb = VN + (size_t)(tb * 4 + h) * 128 * 64; const bf16_t* kb = KNT + (size_t)(tb * 4 + h) * 128 * 64;
        bf16x8 bvf[2][2], bkf[2][2];
#pragma unroll
        for (int t2 = 0; t2 < 2; ++t2)
#pragma unroll
            for (int kk = 0; kk < 2; ++kk) { const size_t o5 = (size_t)((2 * hw + t2) * 16 + fr5) * 64 + kk * 32 + fq5 * 8;
                bvf[t2][kk] = *(const bf16x8*)(vb + o5); bkf[t2][kk] = *(const bf16x8*)(kb + o5); }
        if (hw == 0) { const int tau = dir ? 63 - lane : lane; const size_t gi = (size_t)(dir * 4 + h) * NTOK + m0 + tau;
            float gv = GG[gi];
#pragma unroll
            for (int o = 1; o < 64; o <<= 1) { const float t = __shfl_up(gv, o); if (lane >= o) gv += t; }
            gcl[lane] = gv; betal[lane] = BETA[gi]; GC[gi] = gv; }
        __syncthreads();
        {
            const int fr = lane & 15, fq = lane >> 4;
#pragma unroll 1
            for (int j = 0; j < 8; ++j) {
                const int id = hw * 8 + j, mat = id >> 4, tr = (id >> 2) & 3, tc = id & 3;
                if (mat == 0 && tc > tr) continue;
                const LAS bf16_t* Ap = (mat ? QB : KB) + (tr * 16 + fr) * 136 + fq * 8;
                const LAS bf16_t* Bp = KB + (tc * 16 + fr) * 136 + fq * 8;
                f32x4 acc = {0.f, 0.f, 0.f, 0.f};
#pragma unroll
                for (int kk = 0; kk < 4; ++kk) acc = __builtin_amdgcn_mfma_f32_16x16x32_bf16(*(const LAS bf16x8*)(Ap + kk * 32), *(const LAS bf16x8*)(Bp + kk * 32), acc, 0, 0, 0);
                const int s = tc * 16 + fr; const float gs = gcl[s];
#pragma unroll
                for (int r = 0; r < 4; ++r) { const int c = tr * 16 + fq * 4 + r; const float dec = __expf(fminf(gcl[c] - gs, 0.f));
                    if (mat == 0) Af[c * 68 + s] = (s < c) ? betal[c] * acc[r] * dec : 0.f;
                    else { const int tc_ = dir ? 63 - c : c, ts_ = dir ? 63 - s : s;
                        QK[((size_t)((dir * 192 + tb) * 4 + h) * 64 + tc_) * 64 + ts_] = (bf16_t)f2bf((s <= c) ? acc[r] * dec : 0.f); } }
            }
        }
        __syncthreads();
        LAS float* Mf = (LAS float*)(lds + 17408);
        LAS bf16_t* MU = (LAS bf16_t*)lds;
        LAS float* Tm = (LAS float*)(lds + 9216);
        LAS bf16_t* MW = (LAS bf16_t*)(lds + 52736);
        if (ht < 64) {
            const int blk = ht >> 5, j = ht & 31;
            const LAS float* Ab = Af + blk * (32 * 68 + 32);
            float x[32];
#pragma unroll
            for (int r = 0; r < 32; ++r) {
                float a0 = (r == j) ? 1.f : 0.f, a1 = 0.f, a2 = 0.f, a3 = 0.f;
#pragma unroll
                for (int q = 0; q < (r + 3) / 4; ++q) { const f32x4 av = *(const LAS f32x4*)(Ab + r * 68 + 4 * q);
                    a0 -= av.x * x[4 * q];
                    if (4 * q + 1 < r) a1 -= av.y * x[4 * q + 1];
                    if (4 * q + 2 < r) a2 -= av.z * x[4 * q + 2];
                    if (4 * q + 3 < r) a3 -= av.w * x[4 * q + 3]; }
                x[r] = (a0 + a1) + (a2 + a3);
            }
            LAS float* Mb = Mf + blk * (32 * 68 + 32) + j;
#pragma unroll
            for (int r = 0; r < 32; ++r) Mb[r * 68] = x[r];
        }
        __syncthreads();
        const int br = ht >> 3, bc0 = (ht & 7) * 4;
        {
            f32x4 t = {0.f, 0.f, 0.f, 0.f};
#pragma unroll 8
            for (int q = 0; q < 32; ++q) { const float lv = Af[(32 + br) * 68 + q]; const f32x4 dvv = *(const LAS f32x4*)(Mf + q * 68 + bc0); t = t + dvv * lv; }
            *(LAS f32x4*)(Tm + br * 36 + bc0) = t;
        }
        __syncthreads();
        {
            f32x4 m = {0.f, 0.f, 0.f, 0.f};
#pragma unroll 8
            for (int q = 0; q < 32; ++q) { const float dd = Mf[(32 + br) * 68 + 32 + q]; const f32x4 tt = *(const LAS f32x4*)(Tm + q * 36 + bc0); m = m - tt * dd; }
            *(LAS f32x4*)(Mf + (32 + br) * 68 + bc0) = m;
        }
        __syncthreads();
        {
            const int c = ht >> 2, s0 = (ht & 3) * 16;
#pragma unroll
            for (int k = 0; k < 16; ++k) { const int sidx = s0 + k;
                const float mld = Mf[c * 68 + sidx]; const float m = (c < 32 && sidx >= 32) ? 0.f : mld;
                const float mu = m * betal[sidx], mw = mu * __expf(gcl[sidx]);
                const int tau = dir ? 63 - sidx : sidx;
                MU[c * 72 + tau] = (bf16_t)f2bf(mu); MW[c * 72 + tau] = (bf16_t)f2bf(mw); }
        }
        __syncthreads();
        {
            const int fr = lane & 15, fq = lane >> 4;
            float zl = 0.f; asm volatile("" : "+v"(zl));
            if (pit + G < 768) E3B_LOAD(pit + G);
#pragma unroll
            for (int t2 = 0; t2 < 2; ++t2) {
                const int jcol = (2 * hw + t2) * 16 + fr;
                bf16x8 bv[2], bk[2];
#pragma unroll
                for (int kk = 0; kk < 2; ++kk) { bv[kk] = bvf[t2][kk]; bk[kk] = bkf[t2][kk]; }
#pragma unroll 1
                for (int tr = 0; tr < 4; ++tr) {
                    f32x4 au = {0.f, 0.f, 0.f, 0.f}, aw = {0.f, 0.f, 0.f, 0.f};
#pragma unroll
                    for (int kk = 0; kk < 2; ++kk) {
                        au = __builtin_amdgcn_mfma_f32_16x16x32_bf16(*(const LAS bf16x8*)(MU + (tr * 16 + fr) * 72 + fq * 8 + kk * 32), bv[kk], au, 0, 0, 0);
                        aw = __builtin_amdgcn_mfma_f32_16x16x32_bf16(*(const LAS bf16x8*)(MW + (tr * 16 + fr) * 72 + fq * 8 + kk * 32), bk[kk], aw, 0, 0, 0); }
#pragma unroll
                    for (int r = 0; r < 4; ++r) { const int c = tr * 16 + fq * 4 + r, tauc = dir ? 63 - c : c;
                        const size_t o = ((size_t)dir * NTOK + m0 + tauc) * 512 + h * 128 + jcol;
                        U[o] = (bf16_t)f2bf(au[r] + zl); Wb[o] = (bf16_t)f2bf(aw[r] + zl); }
                }
            }
        }
        __syncthreads();
    }
}

#undef E3B_LOAD
__device__ __forceinline__ void scan_item(const Params& p, int i, int seq, int dir, int h, int sl, unsigned char* lds_raw, int tid, int lane, int wave) {
    asm volatile("" : "+s"(wave));
    asm volatile("" : "+v"(tid), "+v"(lane));
    size_t zo_ = 0; asm volatile("" : "+s"(zo_)); unsigned char* ws_ = p.ws + zo_;
    const bf16_t* QN = (const bf16_t*)(ws_ + WS_QN); const bf16_t* KNT = (const bf16_t*)(ws_ + WS_KNT);
    const bf16_t* U = (const bf16_t*)(ws_ + WS_U); const bf16_t* Wb = (const bf16_t*)(ws_ + WS_W); const bf16_t* QK = (const bf16_t*)(ws_ + WS_QK);
    const float* GC = (const float*)(ws_ + WS_GC); bf16_t* ODN = (bf16_t*)(ws_ + WS_ODN);
    LAS unsigned char* lds = (LAS unsigned char*)lds_raw;
    LAS bf16_t* Wl = (LAS bf16_t*)lds;
    LAS bf16_t* QNl = (LAS bf16_t*)(lds + 17408);
    LAS bf16_t* KTl = (LAS bf16_t*)(lds + 34816);
    LAS bf16_t* QKl = (LAS bf16_t*)(lds + 53248);
    LAS float* egc = (LAS float*)(lds + 62464);
    LAS float* egl = egc + 64;
    LAS bf16_t* ST = (LAS bf16_t*)(lds + 63488);
    LAS bf16_t* VNT = (LAS bf16_t*)(lds + 80896);
    LAS bf16_t* VNST = (LAS bf16_t*)(lds + 85504);
    const bool prompt = seq < 16;
    const int mbase = prompt ? seq * 256 : NPR + (seq - 16) * 2048, nblk = prompt ? 4 : 32;
    const int fr = lane & 15, fq = lane >> 4, tr = wave >> 1, tc = wave & 1;
    f32x4 Sacc[2];
    if (prompt) { Sacc[0] = (f32x4){0.f, 0.f, 0.f, 0.f}; Sacc[1] = Sacc[0]; }
    else { const float* s0 = p.state_a + ((size_t)(((seq - 16) * 2 + i) * 2 + dir) * 4 + h) * 16384;
#pragma unroll
        for (int eb = 0; eb < 2; ++eb)
#pragma unroll
            for (int r = 0; r < 4; ++r) Sacc[eb][r] = s0[(size_t)(wave * 16 + fq * 4 + r) * 128 + sl * 32 + eb * 16 + fr]; }
#pragma unroll
    for (int eb = 0; eb < 2; ++eb) { u32x2 w; w.x = cvt_pk(Sacc[eb][0], Sacc[eb][1]); w.y = cvt_pk(Sacc[eb][2], Sacc[eb][3]);
        *(LAS u32x2*)(ST + (eb * 16 + fr) * 136 + wave * 16 + fq * 4) = w; }
    u32x4 wreg[2], qreg[2], kreg[2], qkreg; unsigned ureg[4]; float gcv = 0.f, glast = 0.f;
#define SCAN_LOAD(n) do { const int tb_ = dir ? nblk - 1 - (n) : (n); const int m0_ = mbase + tb_ * 64; const int tbg_ = m0_ >> 6; \
    _Pragma("unroll") for (int j_ = 0; j_ < 2; ++j_) { const int id_ = tid + 512 * j_; \
        wreg[j_] = *(const u32x4*)(Wb + ((size_t)dir * NTOK + m0_ + (id_ >> 4)) * 512 + h * 128 + (id_ & 15) * 8); \
        qreg[j_] = *(const u32x4*)(QN + (size_t)(m0_ + (id_ >> 4)) * 512 + h * 128 + (id_ & 15) * 8); \
        kreg[j_] = *(const u32x4*)(KNT + ((size_t)(tbg_ * 4 + h) * 128 + (id_ >> 3)) * 64 + (id_ & 7) * 8); } \
    qkreg = *(const u32x4*)(QK + ((size_t)((dir * 192 + tbg_) * 4 + h) * 64 + (tid >> 3)) * 64 + (tid & 7) * 8); \
    _Pragma("unroll") for (int r_ = 0; r_ < 4; ++r_) ureg[r_] = U[((size_t)dir * NTOK + m0_ + tr * 16 + fq * 4 + r_) * 512 + h * 128 + sl * 32 + tc * 16 + fr]; \
    gcv = GC[(size_t)(dir * 4 + h) * NTOK + m0_ + (tid & 63)]; glast = GC[(size_t)(dir * 4 + h) * NTOK + m0_ + (dir ? 0 : 63)]; } while (0)
    SCAN_LOAD(0);
    int cur = 0;
    float zlaund = 0.f; asm volatile("" : "+v"(zlaund));
    for (int n = 0; n < nblk; ++n) {
        const int tb = dir ? nblk - 1 - n : n, m0 = mbase + tb * 64;
#pragma unroll
        for (int j = 0; j < 2; ++j) { const int id = tid + 512 * j;
            *(LAS u32x4*)(Wl + (id >> 4) * 136 + (id & 15) * 8) = wreg[j];
            *(LAS u32x4*)(QNl + (id >> 4) * 136 + (id & 15) * 8) = qreg[j];
            *(LAS u32x4*)(KTl + (id >> 3) * 72 + (id & 7) * 8) = kreg[j]; }
        *(LAS u32x4*)(QKl + (tid >> 3) * 72 + (tid & 7) * 8) = qkreg;
        if (tid < 64) { egc[tid] = __expf(gcv); egl[tid] = __expf(glast - gcv); }
        const float eg = __expf(glast);
        float uv[4];
#pragma unroll
        for (int r = 0; r < 4; ++r) uv[r] = bf2f(ureg[r]);
        __syncthreads();
        if (n + 1 < nblk) SCAN_LOAD(n + 1);
        f32x4 aws = {0.f, 0.f, 0.f, 0.f}, aqs = {0.f, 0.f, 0.f, 0.f};
        {
            const LAS bf16_t* Sp = ST + cur * (32 * 136) + (tc * 16 + fr) * 136 + fq * 8;
            const LAS bf16_t* Wp = Wl + (tr * 16 + fr) * 136 + fq * 8;
            const LAS bf16_t* Qp = QNl + (tr * 16 + fr) * 136 + fq * 8;
#pragma unroll
            for (int kk = 0; kk < 4; ++kk) { const bf16x8 sb = *(const LAS bf16x8*)(Sp + kk * 32);
                aws = __builtin_amdgcn_mfma_f32_16x16x32_bf16(*(const LAS bf16x8*)(Wp + kk * 32), sb, aws, 0, 0, 0);
                aqs = __builtin_amdgcn_mfma_f32_16x16x32_bf16(*(const LAS bf16x8*)(Qp + kk * 32), sb, aqs, 0, 0, 0); }
        }
        float vn[4], el[4], ec[4];
#pragma unroll
        for (int r = 0; r < 4; ++r) { const int c = tr * 16 + fq * 4 + r; vn[r] = uv[r] - aws[r]; el[r] = egl[c]; ec[r] = egc[c]; }
        { u32x2 w; w.x = cvt_pk(vn[0], vn[1]); w.y = cvt_pk(vn[2], vn[3]); *(LAS u32x2*)(VNT + (tc * 16 + fr) * 72 + tr * 16 + fq * 4) = w;
          w.x = cvt_pk(vn[0] * el[0], vn[1] * el[1]); w.y = cvt_pk(vn[2] * el[2], vn[3] * el[3]); *(LAS u32x2*)(VNST + (tc * 16 + fr) * 72 + tr * 16 + fq * 4) = w; }
        __syncthreads();
        {
            f32x4 ao = {0.f, 0.f, 0.f, 0.f};
            const LAS bf16_t* Ap = QKl + (tr * 16 + fr) * 72 + fq * 8;
            const LAS bf16_t* Bp = VNT + (tc * 16 + fr) * 72 + fq * 8;
#pragma unroll
            for (int kk = 0; kk < 2; ++kk) ao = __builtin_amdgcn_mfma_f32_16x16x32_bf16(*(const LAS bf16x8*)(Ap + kk * 32), *(const LAS bf16x8*)(Bp + kk * 32), ao, 0, 0, 0);
            bf16_t* od = ODN + ((size_t)dir * NTOK + m0 + tr * 16 + fq * 4) * 512 + h * 128 + sl * 32 + tc * 16 + fr;
#pragma unroll
            for (int r = 0; r < 4; ++r) od[(size_t)r * 512] = (bf16_t)f2bf(ec[r] * aqs[r] + ao[r]);
        }
        {
            const LAS bf16_t* Ap = KTl + (wave * 16 + fr) * 72 + fq * 8;
#pragma unroll
            for (int eb = 0; eb < 2; ++eb) {
                const LAS bf16_t* Bp = VNST + (eb * 16 + fr) * 72 + fq * 8;
                f32x4 a = Sacc[eb] * eg;
#pragma unroll
                for (int kk = 0; kk < 2; ++kk) a = __builtin_amdgcn_mfma_f32_16x16x32_bf16(*(const LAS bf16x8*)(Ap + kk * 32), *(const LAS bf16x8*)(Bp + kk * 32), a, 0, 0, 0);
                Sacc[eb] = a;
                const float b0 = a[0] + zlaund, b1 = a[1] + zlaund, b2 = a[2] + zlaund, b3 = a[3] + zlaund;
                u32x2 w; w.x = cvt_pk(b0, b1); w.y = cvt_pk(b2, b3);
                *(LAS u32x2*)(ST + (cur ^ 1) * (32 * 136) + (eb * 16 + fr) * 136 + wave * 16 + fq * 4) = w;
            }
        }
        cur ^= 1;
        __syncthreads();
    }
#undef SCAN_LOAD
    if (prompt) { float* so = p.out + OUT_STATE + ((size_t)((seq * 2 + i) * 2 + dir) * 4 + h) * 16384;
#pragma unroll
        for (int eb = 0; eb < 2; ++eb)
#pragma unroll
            for (int r = 0; r < 4; ++r) so[(size_t)(wave * 16 + fq * 4 + r) * 128 + sl * 32 + eb * 16 + fr] = Sacc[eb][r]; }
}

__device__ __forceinline__ void mixer_phase(const Params& p, int l, unsigned char* lds_raw, int tid, int lane, int wave, int bid, int G) {
    asm volatile("" : "+s"(bid), "+s"(G), "+s"(wave));
    size_t zo_ = 0; asm volatile("" : "+s"(zo_)); unsigned char* ws_ = p.ws + zo_;
    asm volatile("" : "+v"(tid), "+v"(lane));
    const bool even = (l & 1) == 0; const int i = l >> 1;
    const bf16_t* PROJ = (const bf16_t*)(ws_ + WS_D); bf16_t* MIX = (bf16_t*)(ws_ + WS_MIX);
    const int nitems = even ? 832 : 384;
    const int vb = (G % 8 == 0) ? (bid % 8) * (G / 8) + bid / 8 : bid;
    const bool dyn = even && G == 256;
    unsigned* qcnt = (unsigned*)p.ws + 3600 + 64 * i;
    volatile LAS unsigned* qword = (volatile LAS unsigned*)((LAS unsigned char*)lds_raw + 131072 + 64 + 16);
    for (int q = vb; q < nitems; ) {
        const int it = dyn ? (q < 128 ? 128 + q : (q < 256 ? q - 128 : q)) : q;
        int kind;
        int b = 0, hq = 0, qb = 0, seq = 0, dir = 0, hh = 0, sl = 0;
        if (even) {
            if (it < 128) { kind = 0; b = it >> 5; hq = (it >> 3) & 3; qb = it & 7; }
            else if (it < 256) { kind = 2; const int j = it - 128; sl = j & 3; hh = (j >> 2) & 3; dir = (j >> 4) & 1; seq = 16 + (j >> 5); }
            else if (it < 320) { kind = 1; const int j = it - 256; b = j >> 2; hq = j & 3; }
            else { kind = 2; const int j = it - 320; sl = j & 3; hh = (j >> 2) & 3; dir = (j >> 4) & 1; seq = j >> 5; }
        } else {
            if (it < 256) { kind = 0; b = it >> 6; hq = (it >> 3) & 7; qb = it & 7; }
            else { kind = 1; const int j = it - 256; b = j >> 3; hq = j & 7; }
        }
        if (kind == 2) scan_item(p, i, seq, dir, hh, sl, lds_raw, tid, lane, wave);
        else {
        const int ld = even ? EVLD : ODN;
        const int qcol = even ? 2048 + hq * 128 : hq * 128;
        const int kvh = even ? (hq >> 1) : (hq >> 2);
        const int kcol = even ? 2560 + kvh * 128 : 1024 + kvh * 128;
        const int vcol = even ? 2816 + kvh * 128 : 1280 + kvh * 128;
        const int ocol = even ? 512 + hq * 128 : hq * 128;
        const float m_init = even ? p.b_sink[i * 4 + hq] / SCALE : -1e30f, l_init = even ? 1.f : 0.f;
        if (kind == 1) {
            const int m0 = b * 256;
            att::attn_body<false>(PROJ + (size_t)m0 * ld + qcol, ld, nullptr, nullptr, 0, 0, PROJ + (size_t)m0 * ld + kcol, PROJ + (size_t)m0 * ld + vcol, ld, 4,
                                  MIX + (size_t)m0 * DM + ocol, DM, m_init, l_init, 0, (char*)lds_raw);
        } else {
            const int s0 = NPR + b * 2048, m0 = s0 + qb * 256;
            const bf16_t* ctx = (const bf16_t*)(ws_ + (even ? WS_CTXB : WS_CTXC)) + (size_t)((b * 2 + i) * 2) * 512 * 256 + kvh * 128;
            if (even) {
                const int loc0 = qb == 0 ? 0 : qb * 256 - 128; const int loce = qb == 7 ? 2048 : qb * 256 + 384; const int nlt = (loce - loc0) >> 6;
                att::attn_body<true>(PROJ + (size_t)m0 * ld + qcol, ld, ctx, ctx + (size_t)512 * 256, 256, 8,
                                     PROJ + (size_t)(s0 + loc0) * ld + kcol, PROJ + (size_t)(s0 + loc0) * ld + vcol, ld, 8 + nlt,
                                     MIX + (size_t)m0 * DM + ocol, DM, m_init, l_init, qb * 256 - loc0, (char*)lds_raw);
            } else {
                att::attn_body<false>(PROJ + (size_t)m0 * ld + qcol, ld, ctx, ctx + (size_t)512 * 256, 256, 8,
                                      PROJ + (size_t)s0 * ld + kcol, PROJ + (size_t)s0 * ld + vcol, ld, 40,
                                      MIX + (size_t)m0 * DM + ocol, DM, m_init, l_init, 0, (char*)lds_raw);
            }
        }
        }
        if (dyn) {
            if (tid == 0) *qword = 256u + __hip_atomic_fetch_add(qcnt, 1u, __ATOMIC_RELAXED, __HIP_MEMORY_SCOPE_AGENT);
            __syncthreads();
            q = (int)*qword;
            __syncthreads();
        } else q += G;
    }
}

__device__ __forceinline__ void e5_phase(const Params& p, int i, int gw, int NGW, int lane) {
    asm volatile("" : "+s"(gw), "+s"(NGW));
    size_t zo_ = 0; asm volatile("" : "+s"(zo_)); unsigned char* ws_ = p.ws + zo_;
    asm volatile("" : "+v"(lane));
    const bf16_t* ODN = (const bf16_t*)(ws_ + WS_ODN); const bf16_t* PROJ = (const bf16_t*)(ws_ + WS_D); bf16_t* MIX = (bf16_t*)(ws_ + WS_MIX);
    const float* ng = p.a_norm_g + i * 128 + (lane & 15) * 8;
    const f32x4 g0 = *(const f32x4*)ng, g1 = *(const f32x4*)(ng + 4);
    for (int m = gw; m < NTOK; m += NGW) {
        const u32x4 a = *(const u32x4*)(ODN + (size_t)m * 512 + lane * 8), b = *(const u32x4*)(ODN + ((size_t)NTOK + m) * 512 + lane * 8);
        const u32x4 gt = *(const u32x4*)(PROJ + (size_t)m * EVLD + 1536 + lane * 8);
        float o[8], gv[8];
        o[0] = bflo(a.x) + bflo(b.x); o[1] = bfhi(a.x) + bfhi(b.x); o[2] = bflo(a.y) + bflo(b.y); o[3] = bfhi(a.y) + bfhi(b.y);
        o[4] = bflo(a.z) + bflo(b.z); o[5] = bfhi(a.z) + bfhi(b.z); o[6] = bflo(a.w) + bflo(b.w); o[7] = bfhi(a.w) + bfhi(b.w);
        gv[0] = bflo(gt.x); gv[1] = bfhi(gt.x); gv[2] = bflo(gt.y); gv[3] = bfhi(gt.y); gv[4] = bflo(gt.z); gv[5] = bfhi(gt.z); gv[6] = bflo(gt.w); gv[7] = bfhi(gt.w);
        float ss = 0.f;
#pragma unroll
        for (int j = 0; j < 8; ++j) ss += o[j] * o[j];
        ss += __shfl_xor(ss, 1); ss += __shfl_xor(ss, 2); ss += __shfl_xor(ss, 4); ss += __shfl_xor(ss, 8);
        const float rstd = rsqrtf(ss * (1.f / 128.f) + EPS);
        float y[8];
#pragma unroll
        for (int j = 0; j < 8; ++j) y[j] = o[j] * rstd * (j < 4 ? g0[j] : g1[j - 4]) * silu_f(gv[j]);
        u32x4 w; w.x = cvt_pk(y[0], y[1]); w.y = cvt_pk(y[2], y[3]); w.z = cvt_pk(y[4], y[5]); w.w = cvt_pk(y[6], y[7]);
        *(u32x4*)(MIX + (size_t)m * DM + lane * 8) = w;
    }
}

__device__ __forceinline__ void o3_phase(const Params& p, int i, int gw, int NGW, int lane) {
    asm volatile("" : "+s"(gw), "+s"(NGW));
    size_t zo_ = 0; asm volatile("" : "+s"(zo_)); unsigned char* ws_ = p.ws + zo_;
    asm volatile("" : "+v"(lane));
    bf16_t* PW = (bf16_t*)(ws_ + WS_D);
    const int axis = lane >> 5, f = lane & 31, d1 = axis * 64 + f, d2 = d1 + 32;
    const float inv = exp2f(-(float)f * (13.287712379549449f / 32.f));
    const float gq1 = p.c_qnorm_g[i * 128 + d1], gq2 = p.c_qnorm_g[i * 128 + d2], gk1 = p.c_knorm_g[i * 128 + d1], gk2 = p.c_knorm_g[i * 128 + d2];
    for (int m = gw; m < NTOK; m += NGW) {
        const bool smp = m >= NPR;
        float cs = 1.f, sn = 0.f;
        if (smp) { const int t = (m - NPR) & 2047; const float pos = (float)(axis ? (t & 63) : (t >> 6)); const float ang = pos * inv; cs = __cosf(ang); sn = __sinf(ang); }
        bf16_t* row = PW + (size_t)m * ODN;
#pragma unroll
        for (int hh = 0; hh < 10; ++hh) {
            bf16_t* q = row + hh * 128;
            const float x1 = bf2f(q[d1]), x2 = bf2f(q[d2]);
            const float rstd = rsqrtf(wave_sum(x1 * x1 + x2 * x2) * (1.f / 128.f) + EPS);
            const float y1 = x1 * rstd * (hh < 8 ? gq1 : gk1), y2 = x2 * rstd * (hh < 8 ? gq2 : gk2);
            if (!smp && hh >= 8) { float* co = p.out + OUT_CC + ((size_t)(((m >> 8) * 2 + i) * 2) * 256 + (m & 255)) * 256 + (hh - 8) * 128; co[d1] = y1; co[d2] = y2; }
            q[d1] = (bf16_t)f2bf(y1 * cs - y2 * sn); q[d2] = (bf16_t)f2bf(y2 * cs + y1 * sn);
        }
    }
}


#define XB_TMO      128
#define XB_XCNT(j)  (256  + 64 * (j))
#define XB_XSUB(j)  (1280 + 64 * (j))
#define XB_XGEN(j)  (2304 + 64 * (j))
#define XB_TOP      3328
#define XB_TOPGEN   3392
#define XCD_BAR_WORDS 3456
#define XB_SPIN_CAP (1u << 18)
__device__ __forceinline__ unsigned xb_ld(unsigned* p)              { return __hip_atomic_load(p, __ATOMIC_RELAXED, __HIP_MEMORY_SCOPE_AGENT); }
__device__ __forceinline__ unsigned xb_add(unsigned* p, unsigned v) { return __hip_atomic_fetch_add(p, v, __ATOMIC_RELAXED, __HIP_MEMORY_SCOPE_AGENT); }
__device__ __forceinline__ unsigned xb_xcc_id() { return (unsigned)__builtin_amdgcn_s_getreg((3 << 11) | 20) & 0xFu; }
#define XB_SPIN(cond, bar) do { unsigned _sp = 0; while (cond) { __builtin_amdgcn_s_sleep(1); \
    if ((++_sp & 255u) == 0u) { if (xb_ld(&(bar)[XB_TMO])) break; if (_sp > XB_SPIN_CAP) { atomicAdd(&(bar)[XB_TMO], 1u); break; } } } } while (0)
struct XcdBarrier { unsigned* bar; unsigned x; volatile LAS unsigned* st; };
__device__ __forceinline__ XcdBarrier xcd_barrier_post(unsigned* bar, volatile LAS unsigned* st) {
    XcdBarrier b; b.bar = bar; b.x = xb_xcc_id(); b.st = st;
    if (threadIdx.x == 0) (void)xb_add(&bar[XB_XCNT(b.x)], 1u);
    return b;
}
__device__ __forceinline__ void xcd_barrier_complete(unsigned* bar, unsigned x, unsigned& nloc, unsigned& nx) {
    const unsigned G = gridDim.x * gridDim.y * gridDim.z;
    unsigned sum, cnt, mine, sp = 0u;
    for (;;) {
        sum = 0u; cnt = 0u; mine = 0u;
#pragma unroll
        for (unsigned j = 0; j < 16; ++j) { const unsigned c = xb_ld(&bar[XB_XCNT(j)]); sum += c; cnt += (c > 0u) ? 1u : 0u; mine = (j == x) ? c : mine; }
        if (sum == G) break;
        __builtin_amdgcn_s_sleep(1);
        if ((++sp & 255u) == 0u) { if (xb_ld(&bar[XB_TMO])) break; if (sp > XB_SPIN_CAP) { atomicAdd(&bar[XB_TMO], 1u); break; } }
    }
    nloc = mine > 0u ? mine : 1u; nx = cnt > 0u ? cnt : 1u;
}
__device__ __forceinline__ void xcd_barrier(const XcdBarrier& b) {
    asm volatile("s_waitcnt vmcnt(0)" ::: "memory");
    __syncthreads();
    if (threadIdx.x == 0) {
        unsigned* bar = b.bar;
        __builtin_amdgcn_s_waitcnt(0);
        unsigned nloc = b.st[0], nx = b.st[1];
        if (nloc == 0u) { xcd_barrier_complete(bar, b.x, nloc, nx); b.st[0] = nloc; b.st[1] = nx; }
        const unsigned old = xb_add(&bar[XB_XSUB(b.x)], 1u);
        const unsigned gen = old / nloc;
        if (old + 1u == (gen + 1u) * nloc) {
            __builtin_amdgcn_fence(__ATOMIC_RELEASE, "agent");
            asm volatile("s_waitcnt vmcnt(0)" ::: "memory");
            const unsigned og = xb_add(&bar[XB_TOP], 1u);
            const unsigned tg = og / nx;
            if (og + 1u == (tg + 1u) * nx) xb_add(&bar[XB_TOPGEN], 1u);
            else XB_SPIN(xb_ld(&bar[XB_TOPGEN]) == tg, bar);
            __builtin_amdgcn_fence(__ATOMIC_ACQUIRE, "agent");
            xb_add(&bar[XB_XGEN(b.x)], 1u);
            asm volatile("s_waitcnt vmcnt(0)" ::: "memory");
        } else {
            XB_SPIN(xb_ld(&bar[XB_XGEN(b.x)]) == gen, bar);
            __builtin_amdgcn_fence(__ATOMIC_ACQUIRE, "agent");
            asm volatile("s_waitcnt vmcnt(0)" ::: "memory");
        }
    }
    __syncthreads();
}
__global__ void __launch_bounds__(512, 2) mega_fwd(Params p) {
    extern __shared__ __attribute__((aligned(16))) unsigned char lds_raw[];
    cg::grid_group grid = cg::this_grid();
#define GSYNC() do { asm volatile("s_waitcnt vmcnt(0) lgkmcnt(0)" ::: "memory"); grid.sync(); __builtin_amdgcn_fence(__ATOMIC_ACQUIRE, "agent"); asm volatile("s_waitcnt vmcnt(0)" ::: "memory"); } while (0)
    const int tid = threadIdx.x, lane = tid & 63, wave = __builtin_amdgcn_readfirstlane(tid >> 6);
    const int G = gridDim.x, bid = blockIdx.x, gw = bid * 8 + wave, NGW = G * 8;

    volatile LAS unsigned* misc = (volatile LAS unsigned*)((LAS unsigned char*)lds_raw + 131072 + 64);
    if (tid == 0) { misc[0] = 0u; misc[1] = 0u; }
    __syncthreads();
    (void)xcd_barrier_post((unsigned*)p.ws, misc);
    phase0(p, lds_raw, tid, lane, wave, bid, G);
#define XSYNC() do { XcdBarrier xb_; xb_.bar = (unsigned*)p.ws; xb_.x = xb_xcc_id(); xb_.st = (volatile LAS unsigned*)((LAS unsigned char*)lds_raw + 131072 + 64); xcd_barrier(xb_); } while (0)
    if (p.ws == nullptr) GSYNC();
    XSYNC();
#pragma unroll 1
    for (int l = 0; l < NLAYERS; ++l) {
        const bool even = (l & 1) == 0; const int i = l >> 1;
        size_t zo = 0; asm volatile("" : "+s"(zo)); unsigned char* ws = p.ws + zo; float* X = p.out + zo;
        bf16_t* H = (bf16_t*)(ws + WS_H); bf16_t* MIX = (bf16_t*)(ws + WS_MIX); bf16_t* DBUF = (bf16_t*)(ws + WS_D);
        const float* modl = (const float*)(ws + WS_MOD) + (size_t)l * 5 * 6144;
        bf16_t* X16 = (bf16_t*)(ws + WS_X16);
        if (l == 0) norm_phase(p.x_prompt, p.x_sample, nullptr, p.norm1_g, modl, 0, 1, H, gw, NGW, lane);
        else norm16_phase(X16, p.norm1_g + l * DM, modl, 0, 1, H, gw, NGW, lane);
        XSYNC();
        {
            const int N = even ? EVN : ODN;
            const bf16_t* Wt = even ? (const bf16_t*)(ws + WS_WEVIN) + (size_t)i * EVN * 1024 : (const bf16_t*)(ws + WS_WODIN) + (size_t)i * ODN * 1024;
            pg8::Gemm g{H, Wt, NTOK, N, DM}; pg8::StaticOrder S; S.init(NTOK, N, G, bid);
            pg8::EpiProj E;
            E.O = DBUF; E.ldc = even ? EVLD : ODN; E.npn_store = even ? 12 : 6;
            E.cache = X + (even ? OUT_CB : OUT_CC) + (size_t)i * 2 * 65536; E.pn_k = even ? 10 : 4; E.pn_lo = even ? 10 : 5; E.pn_hi = even ? 12 : 6;
            E.bg = (float*)(ws + WS_BG); E.pn_bg = even ? 12 : -1;
            pg8::gemm_phase<pg8::EpiProj>((LAS unsigned char*)lds_raw, g, S, E);
        }
        XSYNC();
        if (even) {
            e3a_phase(p, i, lds_raw, tid, lane, wave, bid, G);
            XSYNC();
            e3b_phase(p, lds_raw, tid, lane, wave, bid, G);
            XSYNC();
        } else {
            o3_phase(p, i, gw, NGW, lane);
            XSYNC();
        }
        mixer_phase(p, l, lds_raw, tid, lane, wave, bid, G);
        XSYNC();
        if (even) { e5_phase(p, i, gw, NGW, lane); XSYNC(); }
        {
            const bf16_t* Wt = even ? (const bf16_t*)(ws + WS_WEVOUT) + (size_t)i * 1024 * 1024 : (const bf16_t*)(ws + WS_WODOUT) + (size_t)i * 1024 * 1024;
            pg8::Gemm g{MIX, Wt, NTOK, DM, DM}; pg8::StaticOrder S; S.init(NTOK, DM, G, bid);
            pg8::EpiResid E; E.X = X16; E.gate = modl + 2 * 1024; E.xin_p = l == 0 ? p.x_prompt : nullptr; E.xin_s = l == 0 ? p.x_sample : nullptr;
            pg8::gemm_phase<pg8::EpiResid>((LAS unsigned char*)lds_raw, g, S, E);
        }
        XSYNC();
        norm16_phase(X16, p.norm2_g + l * DM, modl, 3, 4, H, gw, NGW, lane);
        XSYNC();
        {
            pg8::Gemm g{H, (const bf16_t*)(ws + WS_W1) + (size_t)l * DFF * DM, NTOK, DFF, DM}; pg8::StaticOrder S; S.init(NTOK, DFF, G, bid);
            pg8::EpiAct E; E.O = DBUF; E.ldc = DFF;
            pg8::gemm_phase<pg8::EpiAct>((LAS unsigned char*)lds_raw, g, S, E);
        }
        XSYNC();
        {
            pg8::Gemm g{DBUF, (const bf16_t*)(ws + WS_W2) + (size_t)l * DM * DFF, NTOK, DM, DFF}; pg8::StaticOrder S; S.init(NTOK, DM, G, bid);
            pg8::EpiResid E; E.X = X16; E.gate = modl + 5 * 1024; E.xin_p = nullptr; E.xin_s = nullptr;
            pg8::gemm_phase<pg8::EpiResid>((LAS unsigned char*)lds_raw, g, S, E);
        }
        XSYNC();
    }
    final_phase((const bf16_t*)(p.ws + WS_X16), p.out, p.final_g, gw, NGW, lane);
}

extern "C" void kernel_launch(void* const* d_in, const int* in_sizes, int n_in, void* d_out, int out_size, void* d_ws, size_t ws_size, hipStream_t stream) {
    static int grid = 0;
    if (grid == 0) {
        if (n_in != 25 || out_size != 25165824 || ws_size < WS_END) { fprintf(stderr, "kernel_launch: unexpected shapes: n_in %d out %d ws %zu\n", n_in, out_size, ws_size); grid = -1; return; }
        int dev = 0, cus = 0, per_cu = 0;
        hipGetDevice(&dev);
        hipDeviceGetAttribute(&cus, hipDeviceAttributeMultiprocessorCount, dev);
        if (hipFuncSetAttribute((const void*)mega_fwd, hipFuncAttributeMaxDynamicSharedMemorySize, LDS_BYTES) != hipSuccess) { fprintf(stderr, "kernel_launch: hipFuncSetAttribute failed\n"); grid = -1; return; }
        if (hipOccupancyMaxActiveBlocksPerMultiprocessor(&per_cu, (const void*)mega_fwd, 512, LDS_BYTES) != hipSuccess || per_cu < 1) { fprintf(stderr, "kernel_launch: occupancy query says %d\n", per_cu); per_cu = 1; }
        (void)hipGetLastError();
        grid = cus * 1;
    }
    if (grid < 0) return;
    if (hipMemsetAsync(d_ws, 0, 16384, stream) != hipSuccess) { fprintf(stderr, "kernel_launch: memset failed\n"); return; }
    Params p{};
    const float** pp = (const float**)&p;
    for (int k = 0; k < 25; ++k) pp[k] = (const float*)d_in[k];
    p.out = (float*)d_out; p.ws = (unsigned char*)d_ws;
    void* args[] = {&p};
    hipError_t e = hipLaunchCooperativeKernel((const void*)mega_fwd, dim3(grid), dim3(512), args, LDS_BYTES, stream);
    if (e != hipSuccess) fprintf(stderr, "kernel_launch: cooperative launch failed: %s (grid %d)\n", hipGetErrorString(e), grid);
}
```

```cpp
#include <hip/hip_runtime.h>
#include <hip/hip_cooperative_groups.h>
#include <cstdio>
#include <cstdint>
namespace cg = cooperative_groups;

#define LAS __attribute__((address_space(3)))
typedef unsigned short bf16_t;
typedef short bf16x8 __attribute__((ext_vector_type(8)));
typedef short s16x4 __attribute__((ext_vector_type(4)));
typedef float f32x4 __attribute__((ext_vector_type(4)));
typedef float f32x2 __attribute__((ext_vector_type(2)));
typedef float f32x16 __attribute__((ext_vector_type(16)));
typedef unsigned u32x4 __attribute__((ext_vector_type(4)));
typedef unsigned u32x2 __attribute__((ext_vector_type(2)));

constexpr int DM = 1024, NTOK = 12288, NPR = 4096, DFF = 4096;
constexpr int EVN = 3328, EVLD = 3072, ODN = 1536;
constexpr float EPS = 1e-6f;
constexpr float SCALE = 0.088388347648318440f;

constexpr size_t MiB = 1u << 20;
constexpr size_t WS_MOD = 1 * MiB;
constexpr size_t WS_WEVIN = 2 * MiB;
constexpr size_t WS_WEVOUT = 15 * MiB;
constexpr size_t WS_WODIN = 19 * MiB;
constexpr size_t WS_WODOUT = 25 * MiB;
constexpr size_t WS_W1 = 29 * MiB;
constexpr size_t WS_W2 = 61 * MiB;
constexpr size_t WS_CTXB = 93 * MiB;
constexpr size_t WS_CTXC = 97 * MiB;
constexpr size_t WS_H = 101 * MiB;
constexpr size_t WS_MIX = 125 * MiB;
constexpr size_t WS_BG = 149 * MiB;
constexpr size_t WS_BETA = 150 * MiB;
constexpr size_t WS_G = 150 * MiB + 512 * 1024;
constexpr size_t WS_GC = 151 * MiB;
constexpr size_t WS_D = 152 * MiB;
constexpr size_t WS_QN = 224 * MiB;
constexpr size_t WS_KN = 236 * MiB;
constexpr size_t WS_VN = 248 * MiB;
constexpr size_t WS_KNT = 260 * MiB;
constexpr size_t WS_U = 272 * MiB;
constexpr size_t WS_W = 296 * MiB;
constexpr size_t WS_QK = 320 * MiB;
constexpr size_t WS_ODN = 332 * MiB;
constexpr size_t WS_X16 = 356 * MiB;
constexpr size_t WS_END = 380 * MiB;

constexpr size_t OUT_STATE = 12582912, OUT_CB = 16777216, OUT_CC = 20971520;

constexpr int LDS_BYTES = 147456;
#ifndef NLAYERS
#define NLAYERS 4
#endif
#ifndef STOP_PH
#define STOP_PH 99
#endif

__device__ __forceinline__ unsigned cvt_pk(float lo, float hi) { unsigned r; asm volatile("v_cvt_pk_bf16_f32 %0, %1, %2" : "=v"(r) : "v"(lo), "v"(hi)); return r; }
__device__ __forceinline__ unsigned f2bf(float f) { return cvt_pk(f, 0.f) & 0xffffu; }
__device__ __forceinline__ float bf2f(unsigned h) { return __uint_as_float(h << 16); }
__device__ __forceinline__ float bflo(unsigned w) { return __uint_as_float(w << 16); }
__device__ __forceinline__ float bfhi(unsigned w) { return __uint_as_float(w & 0xffff0000u); }
__device__ __forceinline__ float wave_sum(float v) {
#pragma unroll
    for (int o = 1; o < 64; o <<= 1) v += __shfl_xor(v, o);
    return v;
}
__device__ __forceinline__ float silu_f(float x) { return x / (1.f + __expf(-x)); }
#define LDS_WAIT() asm volatile("s_waitcnt lgkmcnt(0)" ::: "memory")

namespace pg8 {
#define PG8_LAS __attribute__((address_space(3)))
constexpr int BM = 256, BK = 64, HALF = 128, HTB = HALF * BK * 2, STAGE_BYTES = 8 * HTB, NXCD = 8, WGM = 8;
__host__ __device__ __forceinline__ int lds_byte(int r, int c) { const int st = (r >> 4) * 2 + (c >> 5), rr = r & 15, cc = c & 31, ob = rr * 64 + cc * 2; return st * 1024 + (ob ^ (((ob >> 9) & 1) << 5)); }
__host__ __device__ __forceinline__ void stage_rc(int b, int& R, int& C) { const int st = b / 1024, sb = b % 1024, swz = sb ^ (((sb >> 9) & 1) << 5); R = (st >> 1) * 16 + swz / 64; C = (st & 1) * 32 + (swz % 64) / 2; }
__host__ __device__ __forceinline__ int perm32(int rho) { const int n = rho >> 4, i = rho & 15; return 8 * (i >> 2) + 4 * n + (i & 3); }
struct Unit { int pm, pn; };
struct Gemm { const bf16_t* A; const bf16_t* Bt; int M, N, K; };
struct StaticOrder {
    int nM, nN, nwg, G, c;
    __device__ void init(int M, int N, int G_, int c_) { nM = M / BM; nN = N / BM; nwg = nM * nN; G = G_; c = c_; }
    __device__ bool next(int i, Unit& u) const {
        const long L = (long)i * G + c; if (L >= nwg) return false;
        int wgid = (int)L; { const int q = nwg / NXCD, r = nwg % NXCD, xcd = wgid % NXCD, off = wgid / NXCD; wgid = (xcd < r ? xcd * (q + 1) : r * (q + 1) + (xcd - r) * q) + off; }
        const int nig = WGM * nN, gid = wgid / nig, fm = gid * WGM, gsz = (nM - fm) < WGM ? (nM - fm) : WGM;
        u.pm = fm + ((wgid % nig) % gsz); u.pn = (wgid % nig) / gsz; return true;
    }
};

struct EpiProj {
    static constexpr bool PERM = true;
    bf16_t* O; int ldc; int npn_store; float* cache; int pn_k, pn_lo, pn_hi; float* bg; int pn_bg;
    __device__ __forceinline__ void operator()(const f32x4 (&acc)[2][2][4][2], const Unit& u, int wr, int wc, int fr, int fq) const {
        const int row0 = u.pm * BM + wr * 64 + fr, colt = u.pn * BM + wc * 32 + 8 * fq;
        const bool st = u.pn < npn_store;
        const bool cf = (u.pm < 16) && (u.pn >= pn_lo) && (u.pn < pn_hi);
        const bool bgf = (u.pn == pn_bg) && (wc == 0) && (fq < 2);
        float* cb = cache + (size_t)(u.pm * 4 + (u.pn - pn_k)) * 65536;
#pragma unroll
        for (int ai = 0; ai < 2; ++ai)
#pragma unroll
            for (int m = 0; m < 4; ++m) {
                const int r = row0 + ai * HALF + m * 16, rt = wr * 64 + fr + ai * HALF + m * 16;
#pragma unroll
                for (int bj = 0; bj < 2; ++bj) {
                    const f32x4 v0 = acc[ai][bj][m][0], v1 = acc[ai][bj][m][1];
                    if (st) { u32x4 w; w.x = cvt_pk(v0[0], v0[1]); w.y = cvt_pk(v0[2], v0[3]); w.z = cvt_pk(v1[0], v1[1]); w.w = cvt_pk(v1[2], v1[3]);
                        *(u32x4*)(O + (size_t)r * ldc + colt + bj * HALF) = w; }
                    if (cf) { float* d = cb + rt * 256 + wc * 32 + 8 * fq + bj * HALF; *(f32x4*)d = v0; *(f32x4*)(d + 4) = v1; }
                    if (bgf && bj == 0) { float* d = bg + (size_t)r * 16 + 8 * fq; *(f32x4*)d = v0; *(f32x4*)(d + 4) = v1; }
                }
            }
    }
};
struct EpiAct {
    static constexpr bool PERM = true;
    bf16_t* O; int ldc;
    __device__ __forceinline__ void operator()(const f32x4 (&acc)[2][2][4][2], const Unit& u, int wr, int wc, int fr, int fq) const {
        const int row0 = u.pm * BM + wr * 64 + fr, colt = u.pn * BM + wc * 32 + 8 * fq;
#pragma unroll
        for (int ai = 0; ai < 2; ++ai)
#pragma unroll
            for (int m = 0; m < 4; ++m) {
                bf16_t* rowp = O + (size_t)(row0 + ai * HALF + m * 16) * ldc + colt;
#pragma unroll
                for (int bj = 0; bj < 2; ++bj) {
                    f32x4 v0 = acc[ai][bj][m][0], v1 = acc[ai][bj][m][1];
#pragma unroll
                    for (int j = 0; j < 4; ++j) { float a = fmaxf(v0[j], 0.f); v0[j] = a * a; float b = fmaxf(v1[j], 0.f); v1[j] = b * b; }
                    u32x4 w; w.x = cvt_pk(v0[0], v0[1]); w.y = cvt_pk(v0[2], v0[3]); w.z = cvt_pk(v1[0], v1[1]); w.w = cvt_pk(v1[2], v1[3]);
                    *(u32x4*)(rowp + bj * HALF) = w;
                }
            }
    }
};
struct EpiResid {
    static constexpr bool PERM = true;
    bf16_t* X; const float* gate; const float* xin_p; const float* xin_s;
    __device__ __forceinline__ void operator()(const f32x4 (&acc)[2][2][4][2], const Unit& u, int wr, int wc, int fr, int fq) const {
        const int row0 = u.pm * BM + wr * 64 + fr, col0 = u.pn * BM + wc * 32 + 8 * fq;
        const int cidx = u.pm < 16 ? 0 : 1 + ((u.pm - 16) >> 3);
        const float* srcb = xin_p ? (u.pm < 16 ? xin_p : xin_s - (size_t)NPR * DM) : nullptr;
        const float* gp = gate + cidx * 6144 + col0;
        f32x4 gv[2][2];
#pragma unroll
        for (int bj = 0; bj < 2; ++bj) { gv[bj][0] = *(const f32x4*)(gp + bj * HALF); gv[bj][1] = *(const f32x4*)(gp + bj * HALF + 4); }
#pragma unroll
        for (int ai = 0; ai < 2; ++ai)
#pragma unroll
            for (int m = 0; m < 4; ++m) {
                const size_t ro = (size_t)(row0 + ai * HALF + m * 16) * DM + col0;
#pragma unroll
                for (int bj = 0; bj < 2; ++bj) { f32x4 x0, x1;
                    if (srcb) { x0 = *(const f32x4*)(srcb + ro + bj * HALF); x1 = *(const f32x4*)(srcb + ro + bj * HALF + 4); }
                    else { const u32x4 xb = *(const u32x4*)(X + ro + bj * HALF); x0 = (f32x4){bflo(xb.x), bfhi(xb.x), bflo(xb.y), bfhi(xb.y)}; x1 = (f32x4){bflo(xb.z), bfhi(xb.z), bflo(xb.w), bfhi(xb.w)}; }
                    x0 = x0 + gv[bj][0] * acc[ai][bj][m][0]; x1 = x1 + gv[bj][1] * acc[ai][bj][m][1];
                    u32x4 w; w.x = cvt_pk(x0.x, x0.y); w.y = cvt_pk(x0.z, x0.w); w.z = cvt_pk(x1.x, x1.y); w.w = cvt_pk(x1.z, x1.w);
                    *(u32x4*)(X + ro + bj * HALF) = w; }
            }
    }
};

template <class Epi>
__device__ __forceinline__ void gemm_phase(PG8_LAS unsigned char* lds, const Gemm g, const StaticOrder& S, const Epi& E) {
    int tid = threadIdx.x; asm volatile("" : "+v"(tid));
    const int wid = __builtin_amdgcn_readfirstlane(tid >> 6), lane = tid & 63, wr = wid >> 2, wc = wid & 3, fr = lane & 15, fq = lane >> 4;
    const int K = g.K, nt = K / BK;
    unsigned voffA[2], voffB[2];
#pragma unroll
    for (int i = 0; i < 2; ++i) { int R, C; stage_rc(tid * 16 + i * 8192, R, C); const int Rb = Epi::PERM ? ((R & ~31) + perm32(R & 31)) : R;
        voffA[i] = (unsigned)(R * K + C) * 2u; voffB[i] = (unsigned)(Rb * K + C) * 2u; }
    const size_t kstep = (size_t)(BK * 2);
    const size_t hstep = (size_t)HALF * K * 2;
    const size_t tstep = 2 * hstep;
    const unsigned ldsw = (unsigned)wid * 1024u;
    const int aoff = lds_byte(wr * 64 + fr, fq * 8), boff = lds_byte(wc * 32 + fr, fq * 8);
#define PG8_SA(b, h) (((b) * 2 + (h)) * HTB)
#define PG8_SB(b, h) ((4 + (b) * 2 + (h)) * HTB)
#define PG8_STAGE(bufoff, gbase, voff) do { _Pragma("unroll") for (int _i = 0; _i < 2; ++_i) \
        __builtin_amdgcn_global_load_lds((const unsigned*)((const char*)(gbase) + (voff)[_i]), (PG8_LAS unsigned*)(lds + (bufoff) + ldsw + _i * 8192), 16, 0, 0); } while (0)
#define PG8_LDA(dst, b, h) do { _Pragma("unroll") for (int m = 0; m < 4; ++m) _Pragma("unroll") for (int k = 0; k < 2; ++k) dst[m][k] = *(const PG8_LAS bf16x8*)(lds + PG8_SA(b, h) + aoff + m * 2048 + k * 1024); } while (0)
#define PG8_LDB(dst, b, h) do { _Pragma("unroll") for (int n = 0; n < 2; ++n) _Pragma("unroll") for (int k = 0; k < 2; ++k) dst[n][k] = *(const PG8_LAS bf16x8*)(lds + PG8_SB(b, h) + boff + n * 2048 + k * 1024); } while (0)
#define PG8_MMA(ai, bj, At, Bt) do { __builtin_amdgcn_s_setprio(1); _Pragma("unroll") for (int m = 0; m < 4; ++m) _Pragma("unroll") for (int n = 0; n < 2; ++n) _Pragma("unroll") for (int k = 0; k < 2; ++k) \
        acc[ai][bj][m][n] = __builtin_amdgcn_mfma_f32_16x16x32_bf16(Bt[n][k], At[m][k], acc[ai][bj][m][n], 0, 0, 0); __builtin_amdgcn_s_setprio(0); } while (0)
#define PG8_WAIT_V(n) asm volatile("s_waitcnt vmcnt(" #n ")" ::: "memory")
#define PG8_WAIT_L(n) asm volatile("s_waitcnt lgkmcnt(" #n ")" ::: "memory")
#define PG8_BAR __builtin_amdgcn_s_barrier()
#define PG8_SCHED __builtin_amdgcn_sched_barrier(0)
    Unit cur, nxt; int ui = 0;
    if (!S.next(0, cur)) return;
    f32x4 acc[2][2][4][2];
#pragma unroll
    for (int a = 0; a < 2; ++a)
#pragma unroll
        for (int b = 0; b < 2; ++b)
#pragma unroll
            for (int m = 0; m < 4; ++m)
#pragma unroll
                for (int n = 0; n < 2; ++n) acc[a][b][m][n] = (f32x4){0.f, 0.f, 0.f, 0.f};
    bf16x8 At[4][2], B0[2][2], B1[2][2];
    const char* cA = (const char*)g.A + (size_t)cur.pm * tstep; const char* cB = (const char*)g.Bt + (size_t)cur.pn * tstep;
    PG8_STAGE(PG8_SB(0, 0), cB, voffB); PG8_STAGE(PG8_SA(0, 0), cA, voffA); PG8_STAGE(PG8_SB(0, 1), cB + hstep, voffB); PG8_STAGE(PG8_SA(0, 1), cA + hstep, voffA);
    if (wr == 1) PG8_BAR;
    PG8_WAIT_V(4); PG8_BAR;
    PG8_STAGE(PG8_SB(1, 0), cB + kstep, voffB); PG8_STAGE(PG8_SA(1, 0), cA + kstep, voffA); PG8_STAGE(PG8_SB(1, 1), cB + hstep + kstep, voffB);
    PG8_WAIT_V(6); PG8_BAR;
    for (;;) {
        const bool has_next = S.next(ui + 1, nxt);
        const char* nA = has_next ? (const char*)g.A + (size_t)nxt.pm * tstep : cA; const char* nB = has_next ? (const char*)g.Bt + (size_t)nxt.pn * tstep : cB;
        for (int t = 0; t < nt; t += 2) {
            const bool last = (t == nt - 2);
            const char* a1 = cA + (size_t)(t + 1) * kstep;
            const char* a2 = last ? nA : cA + (size_t)(t + 2) * kstep; const char* b2 = last ? nB : cB + (size_t)(t + 2) * kstep;
            const char* a3 = a2 + kstep; const char* b3 = b2 + kstep;
            PG8_LDB(B0, 0, 0); PG8_SCHED; PG8_LDA(At, 0, 0); PG8_STAGE(PG8_SA(1, 1), a1 + hstep, voffA);
            PG8_WAIT_L(8); PG8_BAR; PG8_WAIT_L(0); PG8_MMA(0, 0, At, B0); PG8_BAR; PG8_SCHED;
            PG8_LDB(B1, 0, 1); PG8_STAGE(PG8_SB(0, 0), b2, voffB);
            PG8_BAR; PG8_WAIT_L(0); PG8_MMA(0, 1, At, B1); PG8_BAR;
            PG8_LDA(At, 0, 1); PG8_STAGE(PG8_SA(0, 0), a2, voffA);
            PG8_BAR; PG8_WAIT_L(0); PG8_MMA(1, 0, At, B0); PG8_BAR; PG8_SCHED;
            PG8_STAGE(PG8_SB(0, 1), b2 + hstep, voffB);
            PG8_WAIT_V(6); PG8_BAR; PG8_MMA(1, 1, At, B1); PG8_BAR;
            PG8_LDB(B0, 1, 0); PG8_SCHED; PG8_LDA(At, 1, 0); PG8_STAGE(PG8_SA(0, 1), a2 + hstep, voffA);
            PG8_WAIT_L(8); PG8_BAR; PG8_WAIT_L(0); PG8_MMA(0, 0, At, B0); PG8_BAR; PG8_SCHED;
            PG8_LDB(B1, 1, 1); PG8_STAGE(PG8_SB(1, 0), b3, voffB);
            PG8_BAR; PG8_WAIT_L(0); PG8_MMA(0, 1, At, B1); PG8_BAR;
            PG8_LDA(At, 1, 1); PG8_STAGE(PG8_SA(1, 0), a3, voffA);
            PG8_BAR; PG8_WAIT_L(0); PG8_MMA(1, 0, At, B0); PG8_BAR; PG8_SCHED;
            PG8_STAGE(PG8_SB(1, 1), b3 + hstep, voffB);
            PG8_WAIT_V(6); PG8_BAR; PG8_MMA(1, 1, At, B1); PG8_BAR;
        }
        E(acc, cur, wr, wc, fr, fq);
        if (!has_next) break;
#pragma unroll
        for (int a = 0; a < 2; ++a)
#pragma unroll
            for (int b = 0; b < 2; ++b)
#pragma unroll
                for (int m = 0; m < 4; ++m)
#pragma unroll
                    for (int n = 0; n < 2; ++n) acc[a][b][m][n] = (f32x4){0.f, 0.f, 0.f, 0.f};
        cur = nxt; cA = nA; cB = nB; ++ui;
    }
    PG8_WAIT_V(0);
    if (wr == 0) PG8_BAR;
    PG8_BAR;
#undef PG8_SA
#undef PG8_SB
#undef PG8_STAGE
#undef PG8_LDA
#undef PG8_LDB
#undef PG8_MMA
#undef PG8_WAIT_V
#undef PG8_WAIT_L
#undef PG8_BAR
#undef PG8_SCHED
}
}

namespace att {
constexpr int D = 128, NW = 8, QBLK = 32, KVBLK = 64;
constexpr float THR = 8.f;
#ifndef ATT_SDEPTH
#define ATT_SDEPTH 1
#endif
constexpr size_t SHM_V = KVBLK * D * 2, SHM_K = KVBLK * D * 2, SHM_ATTN = 2 * SHM_V + 2 * SHM_K + NW * 64 * 4;
#define KSWZ(row, colB) ((row) * 256 + ((colB) ^ (((row) & 7) << 4)))
#define SBAR() __builtin_amdgcn_sched_barrier(0)
__device__ __forceinline__ int crow(int r, int hi) { return (r & 3) + 8 * (r >> 2) + 4 * hi; }
__device__ __forceinline__ void partialSM(f32x16& p0, f32x16& p1, float& m_reg, float& mn, float& alpha) {
    constexpr float C = SCALE * 1.4426950408889634f;
    float pmax = p0[0];
#pragma unroll
    for (int r = 1; r < 16; ++r) pmax = fmaxf(pmax, p0[r]);
#pragma unroll
    for (int r = 0; r < 16; ++r) pmax = fmaxf(pmax, p1[r]);
    { auto rr = __builtin_amdgcn_permlane32_swap(__float_as_uint(pmax), __float_as_uint(pmax), false, false);
      pmax = fmaxf(__uint_as_float(rr[0]), __uint_as_float(rr[1])); }
    if (__builtin_expect(__all(pmax - m_reg <= THR / SCALE), 1)) { mn = m_reg; alpha = 1.f; }
    else { mn = fmaxf(m_reg, pmax); alpha = __builtin_amdgcn_exp2f((m_reg - mn) * C); m_reg = mn; }
    float mnC = -mn * C;
#pragma unroll
    for (int r = 0; r < 16; ++r) p0[r] = fmaf(p0[r], C, mnC);
#pragma unroll
    for (int r = 0; r < 16; ++r) p1[r] = fmaf(p1[r], C, mnC);
#pragma unroll
    for (int r = 0; r < 16; ++r) p0[r] = __builtin_amdgcn_exp2f(p0[r]);
}
__device__ __forceinline__ void finishSM(f32x16& p0, f32x16& p1, float alpha, float& l_reg, bf16x8& pa0, bf16x8& pa1, bf16x8& pa2, bf16x8& pa3) {
#pragma unroll
    for (int r = 0; r < 16; ++r) p1[r] = __builtin_amdgcn_exp2f(p1[r]);
    float ps = 0;
#pragma unroll
    for (int r = 0; r < 16; ++r) ps += p0[r];
#pragma unroll
    for (int r = 0; r < 16; ++r) ps += p1[r];
    { auto rr = __builtin_amdgcn_permlane32_swap(__float_as_uint(ps), __float_as_uint(ps), false, false);
      ps = __uint_as_float(rr[0]) + __uint_as_float(rr[1]); }
    l_reg = l_reg * alpha + ps;
#define PK4(P, BASE, OUT) do { unsigned a0 = cvt_pk(P[BASE + 0], P[BASE + 1]), a1 = cvt_pk(P[BASE + 2], P[BASE + 3]);   \
    unsigned b0 = cvt_pk(P[BASE + 4], P[BASE + 5]), b1 = cvt_pk(P[BASE + 6], P[BASE + 7]);                              \
    auto r0 = __builtin_amdgcn_permlane32_swap(a0, b0, false, false); auto r1 = __builtin_amdgcn_permlane32_swap(a1, b1, false, false); \
    u32x4 w = {r0[0], r1[0], r0[1], r1[1]}; OUT = *reinterpret_cast<bf16x8*>(&w); } while (0)
    PK4(p0, 0, pa0); PK4(p0, 8, pa1); PK4(p1, 0, pa2); PK4(p1, 8, pa3);
#undef PK4
}
__device__ __forceinline__ void qkt(f32x16& p0, f32x16& p1, const bf16_t* Ks, const bf16x8* qr, int r32, int hi) {
    p0 = f32x16{}; p1 = f32x16{};
#pragma unroll
    for (int d0 = 0; d0 < 8; ++d0) { int cb = (d0 * 16 + hi * 8) * 2;
        bf16x8 b0 = *reinterpret_cast<const bf16x8*>((const char*)Ks + KSWZ(r32, cb));
        bf16x8 b1 = *reinterpret_cast<const bf16x8*>((const char*)Ks + KSWZ(32 + r32, cb));
        p0 = __builtin_amdgcn_mfma_f32_32x32x16_bf16(b0, qr[d0], p0, 0, 0, 0);
        p1 = __builtin_amdgcn_mfma_f32_32x32x16_bf16(b1, qr[d0], p1, 0, 0, 0); }
}
template <bool BAND> __device__ __forceinline__ void maskp(f32x16& p0, f32x16& p1, int t, int nct, int qp, int hi) {
    if constexpr (BAND) {
        if (t >= nct) {
            const int kb = (t - nct) * 64;
#pragma unroll
            for (int r = 0; r < 16; ++r) { const int kp = kb + crow(r, hi); int dd = qp - kp; dd = dd < 0 ? -dd : dd; if (dd > 128) p0[r] = -1e30f;
                int d2 = qp - kp - 32; d2 = d2 < 0 ? -d2 : d2; if (d2 > 128) p1[r] = -1e30f; }
        }
    }
}
__device__ __forceinline__ int v_st(int k, int c) { const int kk = (k & ~0xC) | ((k & 4) << 1) | ((k & 8) >> 1); return ((kk >> 3) * 4 + (c >> 5)) * 512 + ((kk & 7) * 32 + (c & 31)) * 2; }
__device__ __forceinline__ int v_rd_base(int lane) { return ((lane & 3) << 3) | (((lane >> 2) & 3) << 6) | (((lane >> 4) & 1) << 5) | (((lane >> 5) & 1) << 8); }
constexpr int v_rd_off(int d0, int ks, int half) { return d0 * 512 + ks * 4096 + half * 2048; }
template <int OFF> __device__ __forceinline__ s16x4 tr_read(int vb) {
    s16x4 r; asm volatile("ds_read_b64_tr_b16 %0, %1 offset:%2" : "=&v"(r) : "v"(vb), "i"(OFF) : "memory"); return r;
}
template <int D0> __device__ __forceinline__ void pv_one(f32x16& od, int vb, bf16x8 pa0, bf16x8 pa1, bf16x8 pa2, bf16x8 pa3) {
    const s16x4 l0 = tr_read<v_rd_off(D0, 0, 0)>(vb), h0 = tr_read<v_rd_off(D0, 0, 1)>(vb), l1 = tr_read<v_rd_off(D0, 1, 0)>(vb), h1 = tr_read<v_rd_off(D0, 1, 1)>(vb);
    const s16x4 l2 = tr_read<v_rd_off(D0, 2, 0)>(vb), h2 = tr_read<v_rd_off(D0, 2, 1)>(vb), l3 = tr_read<v_rd_off(D0, 3, 0)>(vb), h3 = tr_read<v_rd_off(D0, 3, 1)>(vb);
    asm volatile("s_waitcnt lgkmcnt(0)" ::: "memory"); SBAR();
#define PK(L, H) (bf16x8){L[0], L[1], L[2], L[3], H[0], H[1], H[2], H[3]}
    od = __builtin_amdgcn_mfma_f32_32x32x16_bf16(pa0, PK(l0, h0), od, 0, 0, 0);
    od = __builtin_amdgcn_mfma_f32_32x32x16_bf16(pa1, PK(l1, h1), od, 0, 0, 0);
    od = __builtin_amdgcn_mfma_f32_32x32x16_bf16(pa2, PK(l2, h2), od, 0, 0, 0);
    od = __builtin_amdgcn_mfma_f32_32x32x16_bf16(pa3, PK(l3, h3), od, 0, 0, 0);
#undef PK
}
__device__ __forceinline__ void pv_d0(f32x16* o, int vb, bf16x8 pa0, bf16x8 pa1, bf16x8 pa2, bf16x8 pa3) {
    pv_one<0>(o[0], vb, pa0, pa1, pa2, pa3); pv_one<1>(o[1], vb, pa0, pa1, pa2, pa3); pv_one<2>(o[2], vb, pa0, pa1, pa2, pa3); pv_one<3>(o[3], vb, pa0, pa1, pa2, pa3);
}

template <bool BAND>
__device__ __forceinline__ void attn_body(const bf16_t* __restrict__ Qb, int ldq, const bf16_t* __restrict__ Kc, const bf16_t* __restrict__ Vc, int ldc, int nct,
                                          const bf16_t* __restrict__ Kl, const bf16_t* __restrict__ Vl, int ldl, int NT,
                                          bf16_t* __restrict__ Ob, int ldo, float m_init, float l_init, int qoff, char* lds) {
    int tid = threadIdx.x; asm volatile("" : "+v"(tid));
    const int wid = tid >> 6, lane = tid & 63, r32 = lane & 31, hi = lane >> 5;
    bf16_t* V_lds = (bf16_t*)lds; bf16_t* K_lds = (bf16_t*)(lds + 2 * SHM_V);
    float* wsl = (float*)(lds + 2 * SHM_V + 2 * SHM_K) + wid * 64; float* li_l = wsl; float* al_l = wsl + 32;
    float m_reg = m_init, l_reg = l_init; f32x16 o[4] = {}; bf16x8 qr[8];
    const bf16_t* Qw = Qb + (long)(wid * QBLK + r32) * ldq + hi * 8;
#pragma unroll
    for (int d0 = 0; d0 < 8; ++d0) qr[d0] = *reinterpret_cast<const bf16x8*>(Qw + d0 * 16);
    const int sr = tid >> 4, sc = (tid & 15) * 8, vst0 = v_st(sr, sc), vst1 = v_st(32 + sr, sc);
    const int vb0 = (int)(uintptr_t)V_lds + v_rd_base(lane);
    const int qp = qoff + wid * QBLK + r32;
    const int offc = sr * ldc + sc, offl = sr * ldl + sc;
    constexpr int SDEPTH = ATT_SDEPTH;
    struct { bf16x8 vs0, vs1, ks0, ks1; } sr_[SDEPTH];
#define SLOAD(i, t) do { const bool _c = (t) < nct; const bf16_t* _k = _c ? Kc + (long)(t) * 64 * ldc : Kl + (long)((t) - nct) * 64 * ldl; \
    const bf16_t* _v = _c ? Vc + (long)(t) * 64 * ldc : Vl + (long)((t) - nct) * 64 * ldl; const int _o = _c ? offc : offl; const int _h = (_c ? ldc : ldl) * 32; \
    sr_[i].vs0 = *reinterpret_cast<const bf16x8*>(_v + _o); sr_[i].vs1 = *reinterpret_cast<const bf16x8*>(_v + _o + _h); \
    sr_[i].ks0 = *reinterpret_cast<const bf16x8*>(_k + _o); sr_[i].ks1 = *reinterpret_cast<const bf16x8*>(_k + _o + _h); } while (0)
#define SWRITE(b, i) do { *(bf16x8*)((char*)V_lds + (b) * SHM_V + vst0) = sr_[i].vs0;          \
    *(bf16x8*)((char*)V_lds + (b) * SHM_V + vst1) = sr_[i].vs1; int kc = sc * 2;               \
    *(bf16x8*)((char*)K_lds + (b) * SHM_K + KSWZ(sr, kc)) = sr_[i].ks0;                       \
    *(bf16x8*)((char*)K_lds + (b) * SHM_K + KSWZ(32 + sr, kc)) = sr_[i].ks1; } while (0)
#define SWAIT() do { if constexpr (SDEPTH == 2) asm volatile("s_waitcnt vmcnt(4)" ::: "memory"); else asm volatile("s_waitcnt vmcnt(0)" ::: "memory"); } while (0)
#define RESC(a) do { if (__any((a) < 1.f)) { if (hi == 0) al_l[r32] = (a); asm volatile("s_waitcnt lgkmcnt(0)" ::: "memory"); \
    _Pragma("unroll") for (int d = 0; d < 4; ++d) _Pragma("unroll") for (int r = 0; r < 16; ++r) o[d][r] *= al_l[crow(r, hi)]; } } while (0)
    f32x16 pA0, pA1, pB0, pB1; float mnA, mnB, alA, alB; bf16x8 pa0, pa1, pa2, pa3;
    constexpr int SE = 0, SO = SDEPTH - 1;
    SLOAD(SE, 0); asm volatile("s_waitcnt vmcnt(0)" ::: "memory"); SWRITE(0, SE); __syncthreads();
    qkt(pA0, pA1, K_lds, qr, r32, hi); maskp<BAND>(pA0, pA1, 0, nct, qp, hi); partialSM(pA0, pA1, m_reg, mnA, alA);
    SLOAD(SO, 1); if constexpr (SDEPTH == 2) { if (2 < NT) SLOAD(SE, 2); }
    SWAIT(); SWRITE(1, SO); __syncthreads();
    for (int j = 1; j + 1 < NT; j += 2) {
        SBAR(); qkt(pB0, pB1, (bf16_t*)((char*)K_lds + SHM_K), qr, r32, hi); maskp<BAND>(pB0, pB1, j, nct, qp, hi);
        finishSM(pA0, pA1, alA, l_reg, pa0, pa1, pa2, pa3); SBAR();
        SLOAD(SO, j + SDEPTH); SBAR();
        pv_d0(o, vb0, pa0, pa1, pa2, pa3); partialSM(pB0, pB1, m_reg, mnB, alB);
        __syncthreads(); SWAIT(); SWRITE(0, SE);
        RESC(alB); __syncthreads();
        SBAR(); qkt(pA0, pA1, K_lds, qr, r32, hi); maskp<BAND>(pA0, pA1, j + 1, nct, qp, hi);
        finishSM(pB0, pB1, alB, l_reg, pa0, pa1, pa2, pa3); SBAR();
        if (SDEPTH == 1 || j + 3 < NT) SLOAD(SE, j + 1 + SDEPTH); SBAR();
        pv_d0(o, vb0 + (int)SHM_V, pa0, pa1, pa2, pa3); partialSM(pA0, pA1, m_reg, mnA, alA);
        __syncthreads(); SWAIT(); SWRITE(1, SO);
        RESC(alA); __syncthreads();
    }
    SBAR(); qkt(pB0, pB1, (bf16_t*)((char*)K_lds + SHM_K), qr, r32, hi); maskp<BAND>(pB0, pB1, NT - 1, nct, qp, hi);
    finishSM(pA0, pA1, alA, l_reg, pa0, pa1, pa2, pa3); SBAR();
    pv_d0(o, vb0, pa0, pa1, pa2, pa3); partialSM(pB0, pB1, m_reg, mnB, alB);
    __syncthreads(); RESC(alB);
    finishSM(pB0, pB1, alB, l_reg, pa0, pa1, pa2, pa3); SBAR();
    pv_d0(o, vb0 + (int)SHM_V, pa0, pa1, pa2, pa3);
    if (hi == 0) li_l[r32] = l_reg; asm volatile("s_waitcnt lgkmcnt(0)" ::: "memory");
    float rli[16];
#pragma unroll
    for (int r = 0; r < 16; ++r) rli[r] = __builtin_amdgcn_rcpf(li_l[crow(r, hi)]);
    bf16_t* Ow = Ob + (long)(wid * QBLK) * ldo;
#pragma unroll
    for (int r = 0; r < 16; ++r) { int orow = crow(r, hi);
#pragma unroll
        for (int d0 = 0; d0 < 4; ++d0) Ow[(long)orow * ldo + d0 * 32 + r32] = (bf16_t)f2bf(o[d0][r] * rli[r]); }
    __syncthreads();
#undef SLOAD
#undef SWRITE
#undef SWAIT
#undef RESC
}
}

struct Params {
    const float *x_prompt, *x_sample, *state_a, *cache_b, *cache_c, *c, *c_ctx, *ada_w, *ada_b, *norm1_g, *norm2_g, *final_g,
                *mlp_w1, *mlp_w2, *ev_w_in, *a_conv, *a_log, *a_dt_bias, *a_norm_g, *b_sink, *ev_w_out, *od_w_in, *c_qnorm_g, *c_knorm_g, *od_w_out;
    float* out; unsigned char* ws;
};

template <int MAP>
__device__ __forceinline__ void transpose_item(const float* W, int K, int Nsrc, bf16_t* WT, int nblk, LAS float* scr, int item, int lane) {
    const int kb = item / nblk, nb = item % nblk, k0 = 64 * kb, n0 = 32 * nb;
    const int nd = n0 + (lane & 31);
    int src = nd;
    if (MAP == 1) src = nd < 2048 ? nd : (nd < 3072 ? nd + 16 : (nd < 3088 ? nd - 1024 : -1));
    float tv[32];
#pragma unroll
    for (int i = 0; i < 32; ++i) { const int kk = 2 * i + (lane >> 5); const float wv_ = W[(size_t)(k0 + kk) * Nsrc + (src >= 0 ? src : 0)]; tv[i] = src >= 0 ? wv_ : 0.f; }
#pragma unroll
    for (int i = 0; i < 32; ++i) { const int kk = 2 * i + (lane >> 5); scr[kk * 33 + (lane & 31)] = tv[i]; }
    LDS_WAIT();
    const int c = lane & 7;
#pragma unroll
    for (int j = 0; j < 4; ++j) { const int n = (lane >> 3) + 8 * j; const LAS float* s = scr + (8 * c) * 33 + n;
        u32x4 o; o.x = cvt_pk(s[0 * 33], s[1 * 33]); o.y = cvt_pk(s[2 * 33], s[3 * 33]); o.z = cvt_pk(s[4 * 33], s[5 * 33]); o.w = cvt_pk(s[6 * 33], s[7 * 33]);
        *(u32x4*)(WT + (size_t)(n0 + n) * K + k0 + 8 * c) = o; }
    LDS_WAIT();
}

__device__ __forceinline__ void phase0(const Params& p, unsigned char* lds_raw, int tid, int lane, int wave, int bid, int G) {
    asm volatile("" : "+s"(bid), "+s"(G), "+s"(wave));
    size_t zo_ = 0; asm volatile("" : "+s"(zo_)); unsigned char* ws_ = p.ws + zo_;
    asm volatile("" : "+v"(tid), "+v"(lane));
    LAS unsigned char* lds = (LAS unsigned char*)lds_raw;
    LAS float* SIL = (LAS float*)(lds + 73728);
    LAS float* RED = (LAS float*)(lds + 94208);
    for (int i = tid; i < 5 * 1024; i += 512) { const int c = i >> 10, k = i & 1023; const float v = c == 0 ? p.c_ctx[k] : p.c[(c - 1) * 1024 + k]; SIL[i] = silu_f(v); }
    __syncthreads();
    float* MOD = (float*)(ws_ + WS_MOD);
    for (int it = bid; it < 768; it += G) {
        const int l = it / 192, cgp = it % 192;
        const int col = lane & 31, kh = lane >> 5;
        const float* w = p.ada_w + (size_t)l * 1024 * 6144 + cgp * 32 + col;
        float a0 = 0.f, a1 = 0.f, a2 = 0.f, a3 = 0.f, a4 = 0.f;
        const int kb = wave * 128 + kh;
#pragma unroll 32
        for (int k2 = 0; k2 < 64; ++k2) { const int k = kb + 2 * k2; const float wv = w[(size_t)k * 6144];
            a0 += SIL[k] * wv; a1 += SIL[1024 + k] * wv; a2 += SIL[2048 + k] * wv; a3 += SIL[3072 + k] * wv; a4 += SIL[4096 + k] * wv; }
        a0 += __shfl_xor(a0, 32); a1 += __shfl_xor(a1, 32); a2 += __shfl_xor(a2, 32); a3 += __shfl_xor(a3, 32); a4 += __shfl_xor(a4, 32);
        if (kh == 0) { RED[(wave * 5 + 0) * 32 + col] = a0; RED[(wave * 5 + 1) * 32 + col] = a1; RED[(wave * 5 + 2) * 32 + col] = a2; RED[(wave * 5 + 3) * 32 + col] = a3; RED[(wave * 5 + 4) * 32 + col] = a4; }
        __syncthreads();
        if (tid < 160) { const int c = tid >> 5, cc = tid & 31; float sacc = 0.f;
#pragma unroll
            for (int w8 = 0; w8 < 8; ++w8) sacc += RED[(w8 * 5 + c) * 32 + cc];
            MOD[(l * 5 + c) * 6144 + cgp * 32 + cc] = sacc + p.ada_b[l * 6144 + cgp * 32 + cc]; }
        __syncthreads();
    }
    LAS float* scr = (LAS float*)(lds + wave * 9216);
    const int gw = bid * 8 + wave, NGW = G * 8;
    constexpr int I_EVIN = 16 * 104, I_SQ = 16 * 32, I_ODIN = 16 * 48, I_W1 = 16 * 128, I_W2 = 64 * 32;
    constexpr int NITEMS = 2 * I_EVIN + 2 * I_SQ + 2 * I_ODIN + 2 * I_SQ + 4 * I_W1 + 4 * I_W2;
    for (int it = gw; it < NITEMS; it += NGW) {
        int r = it;
        if (r < 2 * I_EVIN) { const int i = r / I_EVIN; transpose_item<1>(p.ev_w_in + (size_t)i * 1024 * 3088, 1024, 3088, (bf16_t*)(ws_ + WS_WEVIN) + (size_t)i * EVN * 1024, 104, scr, r % I_EVIN, lane); continue; } r -= 2 * I_EVIN;
        if (r < 2 * I_SQ) { const int i = r / I_SQ; transpose_item<0>(p.ev_w_out + (size_t)i * 1024 * 1024, 1024, 1024, (bf16_t*)(ws_ + WS_WEVOUT) + (size_t)i * 1024 * 1024, 32, scr, r % I_SQ, lane); continue; } r -= 2 * I_SQ;
        if (r < 2 * I_ODIN) { const int i = r / I_ODIN; transpose_item<0>(p.od_w_in + (size_t)i * 1024 * 1536, 1024, 1536, (bf16_t*)(ws_ + WS_WODIN) + (size_t)i * 1536 * 1024, 48, scr, r % I_ODIN, lane); continue; } r -= 2 * I_ODIN;
        if (r < 2 * I_SQ) { const int i = r / I_SQ; transpose_item<0>(p.od_w_out + (size_t)i * 1024 * 1024, 1024, 1024, (bf16_t*)(ws_ + WS_WODOUT) + (size_t)i * 1024 * 1024, 32, scr, r % I_SQ, lane); continue; } r -= 2 * I_SQ;
        if (r < 4 * I_W1) { const int i = r / I_W1; transpose_item<0>(p.mlp_w1 + (size_t)i * 1024 * 4096, 1024, 4096, (bf16_t*)(ws_ + WS_W1) + (size_t)i * 4096 * 1024, 128, scr, r % I_W1, lane); continue; } r -= 4 * I_W1;
        { const int i = r / I_W2; transpose_item<0>(p.mlp_w2 + (size_t)i * 4096 * 1024, 4096, 1024, (bf16_t*)(ws_ + WS_W2) + (size_t)i * 1024 * 4096, 32, scr, r % I_W2, lane); }
    }
    const int NC8 = 262144;
    for (int i = bid * 512 + tid; i < 2 * NC8; i += G * 512) {
        const bool isb = i < NC8; const int j = isb ? i : i - NC8;
        const float* s = (isb ? p.cache_b : p.cache_c) + (size_t)j * 8;
        const f32x4 a = *(const f32x4*)s, b = *(const f32x4*)(s + 4);
        u32x4 o; o.x = cvt_pk(a[0], a[1]); o.y = cvt_pk(a[2], a[3]); o.z = cvt_pk(b[0], b[1]); o.w = cvt_pk(b[2], b[3]);
        *(u32x4*)((bf16_t*)(ws_ + (isb ? WS_CTXB : WS_CTXC)) + (size_t)j * 8) = o;
    }
}

__device__ __forceinline__ void norm_phase(const float* xp, const float* xs, float* Xcopy, const float* g, const float* modl, int shift_chunk, int scale_chunk,
                                           bf16_t* H, int gw, int NGW, int lane) {
    asm volatile("" : "+s"(gw), "+s"(NGW));
    asm volatile("" : "+v"(lane));
    for (int m = gw; m < NTOK; m += NGW) {
        const float* src = m < NPR ? xp + (size_t)m * DM : xs + (size_t)(m - NPR) * DM;
        const int cidx = m < NPR ? 0 : 1 + ((m - NPR) >> 11);
        const f32x4* xr = (const f32x4*)src + lane;
        f32x4 v[4]; float s = 0.f;
#pragma unroll
        for (int j = 0; j < 4; ++j) { v[j] = xr[64 * j]; s += (v[j].x * v[j].x + v[j].y * v[j].y) + (v[j].z * v[j].z + v[j].w * v[j].w); }
        const float rstd = rsqrtf(wave_sum(s) * (1.f / DM) + EPS);
        const f32x4* gp = (const f32x4*)g + lane;
        const f32x4* shp = (const f32x4*)(modl + cidx * 6144 + shift_chunk * 1024) + lane;
        const f32x4* scp = (const f32x4*)(modl + cidx * 6144 + scale_chunk * 1024) + lane;
        u32x2* o8 = (u32x2*)(H + (size_t)m * DM) + lane;
#pragma unroll
        for (int j = 0; j < 4; ++j) {
            const f32x4 gg = gp[64 * j], sh = shp[64 * j], sc = scp[64 * j];
            const f32x4 h = v[j] * rstd * gg * (sc + 1.f) + sh;
            u32x2 w; w.x = cvt_pk(h.x, h.y); w.y = cvt_pk(h.z, h.w); o8[64 * j] = w;
            if (Xcopy) ((f32x4*)(Xcopy + (size_t)m * DM) + lane)[64 * j] = v[j];
        }
    }
}
__device__ __forceinline__ void norm16_phase(const bf16_t* X16, const float* g, const float* modl, int shift_chunk, int scale_chunk, bf16_t* H, int gw, int NGW, int lane) {
    asm volatile("" : "+s"(gw), "+s"(NGW));
    asm volatile("" : "+v"(lane));
    for (int m = gw; m < NTOK; m += NGW) {
        const int cidx = m < NPR ? 0 : 1 + ((m - NPR) >> 11);
        const bf16_t* xr = X16 + (size_t)m * DM + lane * 8;
        const u32x4 r0 = *(const u32x4*)xr, r1 = *(const u32x4*)(xr + 512);
        float v[16];
        v[0] = bflo(r0.x); v[1] = bfhi(r0.x); v[2] = bflo(r0.y); v[3] = bfhi(r0.y); v[4] = bflo(r0.z); v[5] = bfhi(r0.z); v[6] = bflo(r0.w); v[7] = bfhi(r0.w);
        v[8] = bflo(r1.x); v[9] = bfhi(r1.x); v[10] = bflo(r1.y); v[11] = bfhi(r1.y); v[12] = bflo(r1.z); v[13] = bfhi(r1.z); v[14] = bflo(r1.w); v[15] = bfhi(r1.w);
        float sq = 0.f;
#pragma unroll
        for (int j = 0; j < 16; ++j) sq += v[j] * v[j];
        const float rstd = rsqrtf(wave_sum(sq) * (1.f / DM) + EPS);
        const float* gp = g + lane * 8; const float* shp = modl + cidx * 6144 + shift_chunk * 1024 + lane * 8; const float* scp = modl + cidx * 6144 + scale_chunk * 1024 + lane * 8;
        u32x4 o[2];
#pragma unroll
        for (int hh = 0; hh < 2; ++hh) {
            const f32x4 ga = *(const f32x4*)(gp + 512 * hh), gb = *(const f32x4*)(gp + 512 * hh + 4), sa = *(const f32x4*)(shp + 512 * hh), sb = *(const f32x4*)(shp + 512 * hh + 4);
            const f32x4 ca = *(const f32x4*)(scp + 512 * hh), cb = *(const f32x4*)(scp + 512 * hh + 4);
            float h8[8];
#pragma unroll
            for (int j = 0; j < 4; ++j) { h8[j] = v[8 * hh + j] * rstd * ga[j] * (ca[j] + 1.f) + sa[j]; h8[4 + j] = v[8 * hh + 4 + j] * rstd * gb[j] * (cb[j] + 1.f) + sb[j]; }
            o[hh].x = cvt_pk(h8[0], h8[1]); o[hh].y = cvt_pk(h8[2], h8[3]); o[hh].z = cvt_pk(h8[4], h8[5]); o[hh].w = cvt_pk(h8[6], h8[7]);
        }
        bf16_t* hr = H + (size_t)m * DM + lane * 8; *(u32x4*)hr = o[0]; *(u32x4*)(hr + 512) = o[1];
    }
}
__device__ __forceinline__ void final_phase(const bf16_t* X16, float* Y, const float* g, int gw, int NGW, int lane) {
    asm volatile("" : "+s"(gw), "+s"(NGW));
    asm volatile("" : "+v"(lane));
    for (int m = gw; m < NTOK; m += NGW) {
        const bf16_t* xr = X16 + (size_t)m * DM + lane * 8;
        const u32x4 r0 = *(const u32x4*)xr, r1 = *(const u32x4*)(xr + 512);
        float v[16];
        v[0] = bflo(r0.x); v[1] = bfhi(r0.x); v[2] = bflo(r0.y); v[3] = bfhi(r0.y); v[4] = bflo(r0.z); v[5] = bfhi(r0.z); v[6] = bflo(r0.w); v[7] = bfhi(r0.w);
        v[8] = bflo(r1.x); v[9] = bfhi(r1.x); v[10] = bflo(r1.y); v[11] = bfhi(r1.y); v[12] = bflo(r1.z); v[13] = bfhi(r1.z); v[14] = bflo(r1.w); v[15] = bfhi(r1.w);
        float sq = 0.f;
#pragma unroll
        for (int j = 0; j < 16; ++j) sq += v[j] * v[j];
        const float rstd = rsqrtf(wave_sum(sq) * (1.f / DM) + EPS);
        float* yr = Y + (size_t)m * DM + lane * 8;
#pragma unroll
        for (int hh = 0; hh < 2; ++hh) { const f32x4 ga = *(const f32x4*)(g + lane * 8 + 512 * hh), gb = *(const f32x4*)(g + lane * 8 + 512 * hh + 4);
            *(f32x4*)(yr + 512 * hh) = (f32x4){v[8 * hh] * rstd * ga[0], v[8 * hh + 1] * rstd * ga[1], v[8 * hh + 2] * rstd * ga[2], v[8 * hh + 3] * rstd * ga[3]};
            *(f32x4*)(yr + 512 * hh + 4) = (f32x4){v[8 * hh + 4] * rstd * gb[0], v[8 * hh + 5] * rstd * gb[1], v[8 * hh + 6] * rstd * gb[2], v[8 * hh + 7] * rstd * gb[3]}; }
    }
}

__device__ __forceinline__ void e3a_phase(const Params& p, int i, unsigned char* lds_raw, int tid, int lane, int wave, int bid, int G) {
    asm volatile("" : "+s"(bid), "+s"(G), "+s"(wave));
    size_t zo_ = 0; asm volatile("" : "+s"(zo_)); unsigned char* ws_ = p.ws + zo_;
    asm volatile("" : "+v"(tid), "+v"(lane));
    const bf16_t* PROJ = (const bf16_t*)(ws_ + WS_D);
    bf16_t* QN = (bf16_t*)(ws_ + WS_QN); bf16_t* KN = (bf16_t*)(ws_ + WS_KN); bf16_t* VN = (bf16_t*)(ws_ + WS_VN); bf16_t* KNT = (bf16_t*)(ws_ + WS_KNT);
    const float* BG = (const float*)(ws_ + WS_BG); float* BETA = (float*)(ws_ + WS_BETA); float* GG = (float*)(ws_ + WS_G);
    LAS float* QF = (LAS float*)lds_raw;
    LAS float* KF = QF + 64 * 132;
    const float* convw = p.a_conv + (size_t)i * 3 * 1536;
    for (int it = bid; it < 768; it += G) {
        const int tb = it >> 2, h = it & 3, m0 = tb * 64;
        const bool first = tb < 64 ? ((tb & 3) == 0) : (((tb - 64) & 31) == 0);
        const bool lastb = tb < 64 ? ((tb & 3) == 3) : (((tb - 64) & 31) == 31);
        const int d = tid & 127, rg = tid >> 7, c0 = rg * 16;
#pragma unroll
        for (int part = 0; part < 3; ++part) {
            const int col = part * 512 + h * 128 + d;
            const float w0 = convw[col], w1 = convw[1536 + col], w2 = convw[3072 + col];
            const bf16_t* src = PROJ + (size_t)m0 * EVLD + col;
            const bool zp = (c0 == 0 && first);
            const float xp_ld = bf2f(src[(long)(zp ? c0 : c0 - 1) * EVLD]);
            float xprev = zp ? 0.f : xp_ld;
            float xcur = bf2f(src[(long)c0 * EVLD]);
            float vy[16];
#pragma unroll
            for (int cc = 0; cc < 16; ++cc) {
                const int c = c0 + cc;
                const bool zn = (c == 63 && lastb);
                const float xn_ld = bf2f(src[(long)(zn ? c : c + 1) * EVLD]);
                const float xnext = zn ? 0.f : xn_ld;
                const float y = silu_f(w0 * xprev + w1 * xcur + w2 * xnext);
                if (part == 0) QF[c * 132 + d] = y; else if (part == 1) KF[c * 132 + d] = y; else vy[cc] = y;
                xprev = xcur; xcur = xnext;
            }
            if (part == 2) {
                u32x4 a, b;
                a.x = cvt_pk(vy[0], vy[1]); a.y = cvt_pk(vy[2], vy[3]); a.z = cvt_pk(vy[4], vy[5]); a.w = cvt_pk(vy[6], vy[7]);
                b.x = cvt_pk(vy[8], vy[9]); b.y = cvt_pk(vy[10], vy[11]); b.z = cvt_pk(vy[12], vy[13]); b.w = cvt_pk(vy[14], vy[15]);
                bf16_t* dv = VN + ((size_t)(tb * 4 + h) * 128 + d) * 64 + c0; *(u32x4*)dv = a; *(u32x4*)(dv + 8) = b;
            }
        }
        __syncthreads();
        {
            const int row = tid >> 3, seg = tid & 7;
            LAS float* qp = QF + row * 132 + seg * 16; LAS float* kp = KF + row * 132 + seg * 16;
            float qv[16], kv[16]; float sq = 0.f, sk = 0.f;
#pragma unroll
            for (int j = 0; j < 16; ++j) { qv[j] = qp[j]; kv[j] = kp[j]; sq += qv[j] * qv[j]; sk += kv[j] * kv[j]; }
            sq += __shfl_xor(sq, 1); sq += __shfl_xor(sq, 2); sq += __shfl_xor(sq, 4);
            sk += __shfl_xor(sk, 1); sk += __shfl_xor(sk, 2); sk += __shfl_xor(sk, 4);
            const float rq = rsqrtf(sq + EPS) * SCALE, rk = rsqrtf(sk + EPS);
            u32x4 a, b;
            a.x = cvt_pk(qv[0] * rq, qv[1] * rq); a.y = cvt_pk(qv[2] * rq, qv[3] * rq); a.z = cvt_pk(qv[4] * rq, qv[5] * rq); a.w = cvt_pk(qv[6] * rq, qv[7] * rq);
            b.x = cvt_pk(qv[8] * rq, qv[9] * rq); b.y = cvt_pk(qv[10] * rq, qv[11] * rq); b.z = cvt_pk(qv[12] * rq, qv[13] * rq); b.w = cvt_pk(qv[14] * rq, qv[15] * rq);
            bf16_t* qd = QN + (size_t)(m0 + row) * 512 + h * 128 + seg * 16; *(u32x4*)qd = a; *(u32x4*)(qd + 8) = b;
#pragma unroll
            for (int j = 0; j < 16; ++j) kv[j] *= rk;
            a.x = cvt_pk(kv[0], kv[1]); a.y = cvt_pk(kv[2], kv[3]); a.z = cvt_pk(kv[4], kv[5]); a.w = cvt_pk(kv[6], kv[7]);
            b.x = cvt_pk(kv[8], kv[9]); b.y = cvt_pk(kv[10], kv[11]); b.z = cvt_pk(kv[12], kv[13]); b.w = cvt_pk(kv[14], kv[15]);
            bf16_t* kd = KN + (size_t)(m0 + row) * 512 + h * 128 + seg * 16; *(u32x4*)kd = a; *(u32x4*)(kd + 8) = b;
#pragma unroll
            for (int j = 0; j < 16; ++j) kp[j] = kv[j];
        }
        if (tid < 128) {
            const int c = tid & 63, dir = tid >> 6, m = m0 + c;
            const float bv = BG[(size_t)m * 16 + dir * 4 + h];
            const float al = BG[(size_t)m * 16 + 8 + dir * 4 + h] + p.a_dt_bias[i * 8 + dir * 4 + h];
            const float sp = al > 20.f ? al : log1pf(__expf(al));
            BETA[(size_t)(dir * 4 + h) * NTOK + m] = 1.f / (1.f + __expf(-bv));
            GG[(size_t)(dir * 4 + h) * NTOK + m] = -__expf(p.a_log[i * 8 + dir * 4 + h]) * sp;
        }
        __syncthreads();
        {
            u32x4 a, b; LAS float* kc = KF + (c0) * 132 + d;
            a.x = cvt_pk(kc[0 * 132], kc[1 * 132]); a.y = cvt_pk(kc[2 * 132], kc[3 * 132]); a.z = cvt_pk(kc[4 * 132], kc[5 * 132]); a.w = cvt_pk(kc[6 * 132], kc[7 * 132]);
            b.x = cvt_pk(kc[8 * 132], kc[9 * 132]); b.y = cvt_pk(kc[10 * 132], kc[11 * 132]); b.z = cvt_pk(kc[12 * 132], kc[13 * 132]); b.w = cvt_pk(kc[14 * 132], kc[15 * 132]);
            bf16_t* dst = KNT + ((size_t)(tb * 4 + h) * 128 + d) * 64 + c0; *(u32x4*)dst = a; *(u32x4*)(dst + 8) = b;
        }
        __syncthreads();
    }
    bf16_t* PW = (bf16_t*)(ws_ + WS_D);
    const int gw = bid * 8 + wave, NGW = G * 8;
    const int axis = lane >> 5, f = lane & 31;
    const float inv = exp2f(-(float)f * (13.287712379549449f / 32.f));
    for (int m = NPR + gw; m < NTOK; m += NGW) {
        const int t = (m - NPR) & 2047; const float pos = (float)(axis ? (t & 63) : (t >> 6));
        const float ang = pos * inv, cs = __cosf(ang), sn = __sinf(ang);
        bf16_t* base = PW + (size_t)m * EVLD + 2048 + axis * 64 + f;
#pragma unroll
        for (int hh = 0; hh < 6; ++hh) { bf16_t* q = base + hh * 128; const float x1 = bf2f(q[0]), x2 = bf2f(q[32]);
            q[0] = (bf16_t)f2bf(x1 * cs - x2 * sn); q[32] = (bf16_t)f2bf(x2 * cs + x1 * sn); }
    }
}

__device__ __forceinline__ void e3b_phase(const Params& p, unsigned char* lds_raw, int tid, int lane, int wave, int bid, int G) {
    asm volatile("" : "+s"(bid), "+s"(G), "+s"(wave));
    asm volatile("" : "+v"(tid), "+v"(lane));
    size_t zo_ = 0; asm volatile("" : "+s"(zo_)); unsigned char* ws_ = p.ws + zo_;
    const bf16_t* QN = (const bf16_t*)(ws_ + WS_QN); const bf16_t* KN = (const bf16_t*)(ws_ + WS_KN); const bf16_t* VN = (const bf16_t*)(ws_ + WS_VN);
    const float* BETA = (const float*)(ws_ + WS_BETA); const float* GG = (const float*)(ws_ + WS_G); float* GC = (float*)(ws_ + WS_GC);
    bf16_t* U = (bf16_t*)(ws_ + WS_U); bf16_t* Wb = (bf16_t*)(ws_ + WS_W); bf16_t* QK = (bf16_t*)(ws_ + WS_QK);
    const int half = wave >> 2, hw = wave & 3, ht = tid & 255;
    LAS unsigned char* lds = (LAS unsigned char*)lds_raw + half * 62464;
    const bf16_t* KNT = (const bf16_t*)(ws_ + WS_KNT);
    LAS bf16_t* KB = (LAS bf16_t*)lds;
    LAS bf16_t* QB = (LAS bf16_t*)(lds + 17408);
    LAS float* Af = (LAS float*)(lds + 34816);
    LAS float* gcl = (LAS float*)(lds + 52224);
    LAS float* betal = gcl + 64;
    u32x4 kreg[4], qreg[4];
#define E3B_LOAD(pp) do { const int it_ = 2 * (pp) + half; const int dir_ = it_ & 1, h_ = (it_ >> 1) & 3, m0_ = (it_ >> 3) * 64; \
    _Pragma("unroll") for (int j_ = 0; j_ < 4; ++j_) { const int id_ = ht + 256 * j_, c_ = id_ >> 4, seg_ = id_ & 15, tau_ = dir_ ? 63 - c_ : c_; \
        kreg[j_] = *(const u32x4*)(KN + (size_t)(m0_ + tau_) * 512 + h_ * 128 + seg_ * 8); \
        qreg[j_] = *(const u32x4*)(QN + (size_t)(m0_ + tau_) * 512 + h_ * 128 + seg_ * 8); } } while (0)
    if (bid < 768) E3B_LOAD(bid);
    for (int pit = bid; pit < 768; pit += G) {
        const int it = 2 * pit + half;
        const int dir = it & 1, h = (it >> 1) & 3, tb = it >> 3, m0 = tb * 64;
#pragma unroll
        for (int j = 0; j < 4; ++j) { const int id = ht + 256 * j, c = id >> 4, seg = id & 15;
            *(LAS u32x4*)(KB + c * 136 + seg * 8) = kreg[j];
            *(LAS u32x4*)(QB + c * 136 + seg * 8) = qreg[j]; }
        const int fr5 = lane & 15, fq5 = lane >> 4;
        const bf16_t* vb = VN + (size_t)(tb * 4 + h) * 128 * 64; const bf16_t* kb = KNT + (size_t)(tb * 4 + h) * 128 * 64;
        bf16x8 bvf[2][2], bkf[2][2];
#pragma unroll
        for (int t2 = 0; t2 < 2; ++t2)
#pragma unroll
            for (int kk = 0; kk < 2; ++kk) { const size_t o5 = (size_t)((2 * hw + t2) * 16 + fr5) * 64 + kk * 32 + fq5 * 8;
                bvf[t2][kk] = *(const bf16x8*)(vb + o5); bkf[t2][kk] = *(const bf16x8*)(kb + o5); }
        if (hw == 0) { const int tau = dir ? 63 - lane : lane; const size_t gi = (size_t)(dir * 4 + h) * NTOK + m0 + tau;
            float gv = GG[gi];
#pragma unroll
            for (int o = 1; o < 64; o <<= 1) { const float t = __shfl_up(gv, o); if (lane >= o) gv += t; }
            gcl[lane] = gv; betal[lane] = BETA[gi]; GC[gi] = gv; }
        __syncthreads();
        {
            const int fr = lane & 15, fq = lane >> 4;
#pragma unroll 1
            for (int j = 0; j < 8; ++j) {
                const int id = hw * 8 + j, mat = id >> 4, tr = (id >> 2) & 3, tc = id & 3;
                if (mat == 0 && tc > tr) continue;
                const LAS bf16_t* Ap = (mat ? QB : KB) + (tr * 16 + fr) * 136 + fq * 8;
                const LAS bf16_t* Bp = KB + (tc * 16 + fr) * 136 + fq * 8;
                f32x4 acc = {0.f, 0.f, 0.f, 0.f};
#pragma unroll
                for (int kk = 0; kk < 4; ++kk) acc = __builtin_amdgcn_mfma_f32_16x16x32_bf16(*(const LAS bf16x8*)(Ap + kk * 32), *(const LAS bf16x8*)(Bp + kk * 32), acc, 0, 0, 0);
                const int s = tc * 16 + fr; const float gs = gcl[s];
#pragma unroll
                for (int r = 0; r < 4; ++r) { const int c = tr * 16 + fq * 4 + r; const float dec = __expf(fminf(gcl[c] - gs, 0.f));
                    if (mat == 0) Af[c * 68 + s] = (s < c) ? betal[c] * acc[r] * dec : 0.f;
                    else { const int tc_ = dir ? 63 - c : c, ts_ = dir ? 63 - s : s;
                        QK[((size_t)((dir * 192 + tb) * 4 + h) * 64 + tc_) * 64 + ts_] = (bf16_t)f2bf((s <= c) ? acc[r] * dec : 0.f); } }
            }
        }
        __syncthreads();
        LAS float* Mf = (LAS float*)(lds + 17408);
        LAS bf16_t* MU = (LAS bf16_t*)lds;
        LAS float* Tm = (LAS float*)(lds + 9216);
        LAS bf16_t* MW = (LAS bf16_t*)(lds + 52736);
        if (ht < 64) {
            const int blk = ht >> 5, j = ht & 31;
            const LAS float* Ab = Af + blk * (32 * 68 + 32);
            float x[32];
#pragma unroll
            for (int r = 0; r < 32; ++r) {
                float a0 = (r == j) ? 1.f : 0.f, a1 = 0.f, a2 = 0.f, a3 = 0.f;
#pragma unroll
                for (int q = 0; q < (r + 3) / 4; ++q) { const f32x4 av = *(const LAS f32x4*)(Ab + r * 68 + 4 * q);
                    a0 -= av.x * x[4 * q];
                    if (4 * q + 1 < r) a1 -= av.y * x[4 * q + 1];
                    if (4 * q + 2 < r) a2 -= av.z * x[4 * q + 2];
                    if (4 * q + 3 < r) a3 -= av.w * x[4 * q + 3]; }
                x[r] = (a0 + a1) + (a2 + a3);
            }
            LAS float* Mb = Mf + blk * (32 * 68 + 32) + j;
#pragma unroll
            for (int r = 0; r < 32; ++r) Mb[r * 68] = x[r];
        }
        __syncthreads();
        const int br = ht >> 3, bc0 = (ht & 7) * 4;
        {
            f32x4 t = {0.f, 0.f, 0.f, 0.f};
#pragma unroll 8
            for (int q = 0; q < 32; ++q) { const float lv = Af[(32 + br) * 68 + q]; const f32x4 dvv = *(const LAS f32x4*)(Mf + q * 68 + bc0); t = t + dvv * lv; }
            *(LAS f32x4*)(Tm + br * 36 + bc0) = t;
        }
        __syncthreads();
        {
            f32x4 m = {0.f, 0.f, 0.f, 0.f};
#pragma unroll 8
            for (int q = 0; q < 32; ++q) { const float dd = Mf[(32 + br) * 68 + 32 + q]; const f32x4 tt = *(const LAS f32x4*)(Tm + q * 36 + bc0); m = m - tt * dd; }
            *(LAS f32x4*)(Mf + (32 + br) * 68 + bc0) = m;
        }
        __syncthreads();
        {
            const int c = ht >> 2, s0 = (ht & 3) * 16;
#pragma unroll
            for (int k = 0; k < 16; ++k) { const int sidx = s0 + k;
                const float mld = Mf[c * 68 + sidx]; const float m = (c < 32 && sidx >= 32) ? 0.f : mld;
                const float mu = m * betal[sidx], mw = mu * __expf(gcl[sidx]);
                const int tau = dir ? 63 - sidx : sidx;
                MU[c * 72 + tau] = (bf16_t)f2bf(mu); MW[c * 72 + tau] = (bf16_t)f2bf(mw); }
        }
        __syncthreads();
        {
            const int fr = lane & 15, fq = lane >> 4;
            float zl = 0.f; asm volatile("" : "+v"(zl));
            if (pit + G < 768) E3B_LOAD(pit + G);
#pragma unroll
            for (int t2 = 0; t2 < 2; ++t2) {
                const int jcol = (2 * hw + t2) * 16 + fr;
                bf16x8 bv[2], bk[2];
#pragma unroll
                for (int kk = 0; kk < 2; ++kk) { bv[kk] = bvf[t2][kk]; bk[kk] = bkf[t2][kk]; }
#pragma unroll 1
                for (int tr = 0; tr < 4; ++tr) {
                    f32x4 au = {0.f, 0.f, 0.f, 0.f}, aw = {0.f, 0.f, 0.f, 0.f};
#pragma unroll
                    for (int kk = 0; kk < 2; ++kk) {
                        au = __builtin_amdgcn_mfma_f32_16x16x32_bf16(*(const LAS bf16x8*)(MU + (tr * 16 + fr) * 72 + fq * 8 + kk * 32), bv[kk], au, 0, 0, 0);
                        aw = __builtin_amdgcn_mfma_f32_16x16x32_bf16(*(const LAS bf16x8*)(MW + (tr * 16 + fr) * 72 + fq * 8 + kk * 32), bk[kk], aw, 0, 0, 0); }
#pragma unroll
                    for (int r = 0; r < 4; ++r) { const int c = tr * 16 + fq * 4 + r, tauc = dir ? 63 - c : c;
                        const size_t o = ((size_t)dir * NTOK + m0 + tauc) * 512 + h * 128 + jcol;
                        U[o] = (bf16_t)f2bf(au[r] + zl); Wb[o] = (bf16_t)f2bf(aw[r] + zl); }
                }
            }
        }
        __syncthreads();
    }
}

#undef E3B_LOAD
__device__ __forceinline__ void scan_item(const Params& p, int i, int seq, int dir, int h, int sl, unsigned char* lds_raw, int tid, int lane, int wave) {
    asm volatile("" : "+s"(wave));
    asm volatile("" : "+v"(tid), "+v"(lane));
    size_t zo_ = 0; asm volatile("" : "+s"(zo_)); unsigned char* ws_ = p.ws + zo_;
    const bf16_t* QN = (const bf16_t*)(ws_ + WS_QN); const bf16_t* KNT = (const bf16_t*)(ws_ + WS_KNT);
    const bf16_t* U = (const bf16_t*)(ws_ + WS_U); const bf16_t* Wb = (const bf16_t*)(ws_ + WS_W); const bf16_t* QK = (const bf16_t*)(ws_ + WS_QK);
    const float* GC = (const float*)(ws_ + WS_GC); bf16_t* ODN = (bf16_t*)(ws_ + WS_ODN);
    LAS unsigned char* lds = (LAS unsigned char*)lds_raw;
    LAS bf16_t* Wl = (LAS bf16_t*)lds;
    LAS bf16_t* QNl = (LAS bf16_t*)(lds + 17408);
    LAS bf16_t* KTl = (LAS bf16_t*)(lds + 34816);
    LAS bf16_t* QKl = (LAS bf16_t*)(lds + 53248);
    LAS float* egc = (LAS float*)(lds + 62464);
    LAS float* egl = egc + 64;
    LAS bf16_t* ST = (LAS bf16_t*)(lds + 63488);
    LAS bf16_t* VNT = (LAS bf16_t*)(lds + 80896);
    LAS bf16_t* VNST = (LAS bf16_t*)(lds + 85504);
    const bool prompt = seq < 16;
    const int mbase = prompt ? seq * 256 : NPR + (seq - 16) * 2048, nblk = prompt ? 4 : 32;
    const int fr = lane & 15, fq = lane >> 4, tr = wave >> 1, tc = wave & 1;
    f32x4 Sacc[2];
    if (prompt) { Sacc[0] = (f32x4){0.f, 0.f, 0.f, 0.f}; Sacc[1] = Sacc[0]; }
    else { const float* s0 = p.state_a + ((size_t)(((seq - 16) * 2 + i) * 2 + dir) * 4 + h) * 16384;
#pragma unroll
        for (int eb = 0; eb < 2; ++eb)
#pragma unroll
            for (int r = 0; r < 4; ++r) Sacc[eb][r] = s0[(size_t)(wave * 16 + fq * 4 + r) * 128 + sl * 32 + eb * 16 + fr]; }
#pragma unroll
    for (int eb = 0; eb < 2; ++eb) { u32x2 w; w.x = cvt_pk(Sacc[eb][0], Sacc[eb][1]); w.y = cvt_pk(Sacc[eb][2], Sacc[eb][3]);
        *(LAS u32x2*)(ST + (eb * 16 + fr) * 136 + wave * 16 + fq * 4) = w; }
    u32x4 wreg[2], qreg[2], kreg[2], qkreg; unsigned ureg[4]; float gcv = 0.f, glast = 0.f;
#define SCAN_LOAD(n) do { const int tb_ = dir ? nblk - 1 - (n) : (n); const int m0_ = mbase + tb_ * 64; const int tbg_ = m0_ >> 6; \
    _Pragma("unroll") for (int j_ = 0; j_ < 2; ++j_) { const int id_ = tid + 512 * j_; \
        wreg[j_] = *(const u32x4*)(Wb + ((size_t)dir * NTOK + m0_ + (id_ >> 4)) * 512 + h * 128 + (id_ & 15) * 8); \
        qreg[j_] = *(const u32x4*)(QN + (size_t)(m0_ + (id_ >> 4)) * 512 + h * 128 + (id_ & 15) * 8); \
        kreg[j_] = *(const u32x4*)(KNT + ((size_t)(tbg_ * 4 + h) * 128 + (id_ >> 3)) * 64 + (id_ & 7) * 8); } \
    qkreg = *(const u32x4*)(QK + ((size_t)((dir * 192 + tbg_) * 4 + h) * 64 + (tid >> 3)) * 64 + (tid & 7) * 8); \
    _Pragma("unroll") for (int r_ = 0; r_ < 4; ++r_) ureg[r_] = U[((size_t)dir * NTOK + m0_ + tr * 16 + fq * 4 + r_) * 512 + h * 128 + sl * 32 + tc * 16 + fr]; \
    gcv = GC[(size_t)(dir * 4 + h) * NTOK + m0_ + (tid & 63)]; glast = GC[(size_t)(dir * 4 + h) * NTOK + m0_ + (dir ? 0 : 63)]; } while (0)
    SCAN_LOAD(0);
    int cur = 0;
    float zlaund = 0.f; asm volatile("" : "+v"(zlaund));
    for (int n = 0; n < nblk; ++n) {
        const int tb = dir ? nblk - 1 - n : n, m0 = mbase + tb * 64;
#pragma unroll
        for (int j = 0; j < 2; ++j) { const int id = tid + 512 * j;
            *(LAS u32x4*)(Wl + (id >> 4) * 136 + (id & 15) * 8) = wreg[j];
            *(LAS u32x4*)(QNl + (id >> 4) * 136 + (id & 15) * 8) = qreg[j];
            *(LAS u32x4*)(KTl + (id >> 3) * 72 + (id & 7) * 8) = kreg[j]; }
        *(LAS u32x4*)(QKl + (tid >> 3) * 72 + (tid & 7) * 8) = qkreg;
        if (tid < 64) { egc[tid] = __expf(gcv); egl[tid] = __expf(glast - gcv); }
        const float eg = __expf(glast);
        float uv[4];
#pragma unroll
        for (int r = 0; r < 4; ++r) uv[r] = bf2f(ureg[r]);
        __syncthreads();
        if (n + 1 < nblk) SCAN_LOAD(n + 1);
        f32x4 aws = {0.f, 0.f, 0.f, 0.f}, aqs = {0.f, 0.f, 0.f, 0.f};
        {
            const LAS bf16_t* Sp = ST + cur * (32 * 136) + (tc * 16 + fr) * 136 + fq * 8;
            const LAS bf16_t* Wp = Wl + (tr * 16 + fr) * 136 + fq * 8;
            const LAS bf16_t* Qp = QNl + (tr * 16 + fr) * 136 + fq * 8;
#pragma unroll
            for (int kk = 0; kk < 4; ++kk) { const bf16x8 sb = *(const LAS bf16x8*)(Sp + kk * 32);
                aws = __builtin_amdgcn_mfma_f32_16x16x32_bf16(*(const LAS bf16x8*)(Wp + kk * 32), sb, aws, 0, 0, 0);
                aqs = __builtin_amdgcn_mfma_f32_16x16x32_bf16(*(const LAS bf16x8*)(Qp + kk * 32), sb, aqs, 0, 0, 0); }
        }
        float vn[4], el[4], ec[4];
#pragma unroll
        for (int r = 0; r < 4; ++r) { const int c = tr * 16 + fq * 4 + r; vn[r] = uv[r] - aws[r]; el[r] = egl[c]; ec[r] = egc[c]; }
        { u32x2 w; w.x = cvt_pk(vn[0], vn[1]); w.y = cvt_pk(vn[2], vn[3]); *(LAS u32x2*)(VNT + (tc * 16 + fr) * 72 + tr * 16 + fq * 4) = w;
          w.x = cvt_pk(vn[0] * el[0], vn[1] * el[1]); w.y = cvt_pk(vn[2] * el[2], vn[3] * el[3]); *(LAS u32x2*)(VNST + (tc * 16 + fr) * 72 + tr * 16 + fq * 4) = w; }
        __syncthreads();
        {
            f32x4 ao = {0.f, 0.f, 0.f, 0.f};
            const LAS bf16_t* Ap = QKl + (tr * 16 + fr) * 72 + fq * 8;
            const LAS bf16_t* Bp = VNT + (tc * 16 + fr) * 72 + fq * 8;
#pragma unroll
            for (int kk = 0; kk < 2; ++kk) ao = __builtin_amdgcn_mfma_f32_16x16x32_bf16(*(const LAS bf16x8*)(Ap + kk * 32), *(const LAS bf16x8*)(Bp + kk * 32), ao, 0, 0, 0);
            bf16_t* od = ODN + ((size_t)dir * NTOK + m0 + tr * 16 + fq * 4) * 512 + h * 128 + sl * 32 + tc * 16 + fr;
#pragma unroll
            for (int r = 0; r < 4; ++r) od[(size_t)r * 512] = (bf16_t)f2bf(ec[r] * aqs[r] + ao[r]);
        }
        {
            const LAS bf16_t* Ap = KTl + (wave * 16 + fr) * 72 + fq * 8;
#pragma unroll
            for (int eb = 0; eb < 2; ++eb) {
                const LAS bf16_t* Bp = VNST + (eb * 16 + fr) * 72 + fq * 8;
                f32x4 a = Sacc[eb] * eg;
#pragma unroll
                for (int kk = 0; kk < 2; ++kk) a = __builtin_amdgcn_mfma_f32_16x16x32_bf16(*(const LAS bf16x8*)(Ap + kk * 32), *(const LAS bf16x8*)(Bp + kk * 32), a, 0, 0, 0);
                Sacc[eb] = a;
                const float b0 = a[0] + zlaund, b1 = a[1] + zlaund, b2 = a[2] + zlaund, b3 = a[3] + zlaund;
                u32x2 w; w.x = cvt_pk(b0, b1); w.y = cvt_pk(b2, b3);
                *(LAS u32x2*)(ST + (cur ^ 1) * (32 * 136) + (eb * 16 + fr) * 136 + wave * 16 + fq * 4) = w;
            }
        }
        cur ^= 1;
        __syncthreads();
    }
#undef SCAN_LOAD
    if (prompt) { float* so = p.out + OUT_STATE + ((size_t)((seq * 2 + i) * 2 + dir) * 4 + h) * 16384;
#pragma unroll
        for (int eb = 0; eb < 2; ++eb)
#pragma unroll
            for (int r = 0; r < 4; ++r) so[(size_t)(wave * 16 + fq * 4 + r) * 128 + sl * 32 + eb * 16 + fr] = Sacc[eb][r]; }
}

__device__ __forceinline__ void mixer_phase(const Params& p, int l, unsigned char* lds_raw, int tid, int lane, int wave, int bid, int G) {
    asm volatile("" : "+s"(bid), "+s"(G), "+s"(wave));
    size_t zo_ = 0; asm volatile("" : "+s"(zo_)); unsigned char* ws_ = p.ws + zo_;
    asm volatile("" : "+v"(tid), "+v"(lane));
    const bool even = (l & 1) == 0; const int i = l >> 1;
    const bf16_t* PROJ = (const bf16_t*)(ws_ + WS_D); bf16_t* MIX = (bf16_t*)(ws_ + WS_MIX);
    const int nitems = even ? 832 : 384;
    const int vb = (G % 8 == 0) ? (bid % 8) * (G / 8) + bid / 8 : bid;
    const bool dyn = even && G == 256;
    unsigned* qcnt = (unsigned*)p.ws + 3600 + 64 * i;
    volatile LAS unsigned* qword = (volatile LAS unsigned*)((LAS unsigned char*)lds_raw + 131072 + 64 + 16);
    for (int q = vb; q < nitems; ) {
        const int it = dyn ? (q < 128 ? 128 + q : (q < 256 ? q - 128 : q)) : q;
        int kind;
        int b = 0, hq = 0, qb = 0, seq = 0, dir = 0, hh = 0, sl = 0;
        if (even) {
            if (it < 128) { kind = 0; b = it >> 5; hq = (it >> 3) & 3; qb = it & 7; }
            else if (it < 256) { kind = 2; const int j = it - 128; sl = j & 3; hh = (j >> 2) & 3; dir = (j >> 4) & 1; seq = 16 + (j >> 5); }
            else if (it < 320) { kind = 1; const int j = it - 256; b = j >> 2; hq = j & 3; }
            else { kind = 2; const int j = it - 320; sl = j & 3; hh = (j >> 2) & 3; dir = (j >> 4) & 1; seq = j >> 5; }
        } else {
            if (it < 256) { kind = 0; b = it >> 6; hq = (it >> 3) & 7; qb = it & 7; }
            else { kind = 1; const int j = it - 256; b = j >> 3; hq = j & 7; }
        }
        if (kind == 2) scan_item(p, i, seq, dir, hh, sl, lds_raw, tid, lane, wave);
        else {
        const int ld = even ? EVLD : ODN;
        const int qcol = even ? 2048 + hq * 128 : hq * 128;
        const int kvh = even ? (hq >> 1) : (hq >> 2);
        const int kcol = even ? 2560 + kvh * 128 : 1024 + kvh * 128;
        const int vcol = even ? 2816 + kvh * 128 : 1280 + kvh * 128;
        const int ocol = even ? 512 + hq * 128 : hq * 128;
        const float m_init = even ? p.b_sink[i * 4 + hq] / SCALE : -1e30f, l_init = even ? 1.f : 0.f;
        if (kind == 1) {
            const int m0 = b * 256;
            att::attn_body<false>(PROJ + (size_t)m0 * ld + qcol, ld, nullptr, nullptr, 0, 0, PROJ + (size_t)m0 * ld + kcol, PROJ + (size_t)m0 * ld + vcol, ld, 4,
                                  MIX + (size_t)m0 * DM + ocol, DM, m_init, l_init, 0, (char*)lds_raw);
        } else {
            const int s0 = NPR + b * 2048, m0 = s0 + qb * 256;
            const bf16_t* ctx = (const bf16_t*)(ws_ + (even ? WS_CTXB : WS_CTXC)) + (size_t)((b * 2 + i) * 2) * 512 * 256 + kvh * 128;
            if (even) {
                const int loc0 = qb == 0 ? 0 : qb * 256 - 128; const int loce = qb == 7 ? 2048 : qb * 256 + 384; const int nlt = (loce - loc0) >> 6;
                att::attn_body<true>(PROJ + (size_t)m0 * ld + qcol, ld, ctx, ctx + (size_t)512 * 256, 256, 8,
                                     PROJ + (size_t)(s0 + loc0) * ld + kcol, PROJ + (size_t)(s0 + loc0) * ld + vcol, ld, 8 + nlt,
                                     MIX + (size_t)m0 * DM + ocol, DM, m_init, l_init, qb * 256 - loc0, (char*)lds_raw);
            } else {
                att::attn_body<false>(PROJ + (size_t)m0 * ld + qcol, ld, ctx, ctx + (size_t)512 * 256, 256, 8,
                                      PROJ + (size_t)s0 * ld + kcol, PROJ + (size_t)s0 * ld + vcol, ld, 40,
                                      MIX + (size_t)m0 * DM + ocol, DM, m_init, l_init, 0, (char*)lds_raw);
            }
        }
        }
        if (dyn) {
            if (tid == 0) *qword = 256u + __hip_atomic_fetch_add(qcnt, 1u, __ATOMIC_RELAXED, __HIP_MEMORY_SCOPE_AGENT);
            __syncthreads();
            q = (int)*qword;
            __syncthreads();
        } else q += G;
    }
}

__device__ __forceinline__ void e5_phase(const Params& p, int i, int gw, int NGW, int lane) {
    asm volatile("" : "+s"(gw), "+s"(NGW));
    size_t zo_ = 0; asm volatile("" : "+s"(zo_)); unsigned char* ws_ = p.ws + zo_;
    asm volatile("" : "+v"(lane));
    const bf16_t* ODN = (const bf16_t*)(ws_ + WS_ODN); const bf16_t* PROJ = (const bf16_t*)(ws_ + WS_D); bf16_t* MIX = (bf16_t*)(ws_ + WS_MIX);
    const float* ng = p.a_norm_g + i * 128 + (lane & 15) * 8;
    const f32x4 g0 = *(const f32x4*)ng, g1 = *(const f32x4*)(ng + 4);
    for (int m = gw; m < NTOK; m += NGW) {
        const u32x4 a = *(const u32x4*)(ODN + (size_t)m * 512 + lane * 8), b = *(const u32x4*)(ODN + ((size_t)NTOK + m) * 512 + lane * 8);
        const u32x4 gt = *(const u32x4*)(PROJ + (size_t)m * EVLD + 1536 + lane * 8);
        float o[8], gv[8];
        o[0] = bflo(a.x) + bflo(b.x); o[1] = bfhi(a.x) + bfhi(b.x); o[2] = bflo(a.y) + bflo(b.y); o[3] = bfhi(a.y) + bfhi(b.y);
        o[4] = bflo(a.z) + bflo(b.z); o[5] = bfhi(a.z) + bfhi(b.z); o[6] = bflo(a.w) + bflo(b.w); o[7] = bfhi(a.w) + bfhi(b.w);
        gv[0] = bflo(gt.x); gv[1] = bfhi(gt.x); gv[2] = bflo(gt.y); gv[3] = bfhi(gt.y); gv[4] = bflo(gt.z); gv[5] = bfhi(gt.z); gv[6] = bflo(gt.w); gv[7] = bfhi(gt.w);
        float ss = 0.f;
#pragma unroll
        for (int j = 0; j < 8; ++j) ss += o[j] * o[j];
        ss += __shfl_xor(ss, 1); ss += __shfl_xor(ss, 2); ss += __shfl_xor(ss, 4); ss += __shfl_xor(ss, 8);
        const float rstd = rsqrtf(ss * (1.f / 128.f) + EPS);
        float y[8];
#pragma unroll
        for (int j = 0; j < 8; ++j) y[j] = o[j] * rstd * (j < 4 ? g0[j] : g1[j - 4]) * silu_f(gv[j]);
        u32x4 w; w.x = cvt_pk(y[0], y[1]); w.y = cvt_pk(y[2], y[3]); w.z = cvt_pk(y[4], y[5]); w.w = cvt_pk(y[6], y[7]);
        *(u32x4*)(MIX + (size_t)m * DM + lane * 8) = w;
    }
}

__device__ __forceinline__ void o3_phase(const Params& p, int i, int gw, int NGW, int lane) {
    asm volatile("" : "+s"(gw), "+s"(NGW));
    size_t zo_ = 0; asm volatile("" : "+s"(zo_)); unsigned char* ws_ = p.ws + zo_;
    asm volatile("" : "+v"(lane));
    bf16_t* PW = (bf16_t*)(ws_ + WS_D);
    const int axis = lane >> 5, f = lane & 31, d1 = axis * 64 + f, d2 = d1 + 32;
    const float inv = exp2f(-(float)f * (13.287712379549449f / 32.f));
    const float gq1 = p.c_qnorm_g[i * 128 + d1], gq2 = p.c_qnorm_g[i * 128 + d2], gk1 = p.c_knorm_g[i * 128 + d1], gk2 = p.c_knorm_g[i * 128 + d2];
    for (int m = gw; m < NTOK; m += NGW) {
        const bool smp = m >= NPR;
        float cs = 1.f, sn = 0.f;
        if (smp) { const int t = (m - NPR) & 2047; const float pos = (float)(axis ? (t & 63) : (t >> 6)); const float ang = pos * inv; cs = __cosf(ang); sn = __sinf(ang); }
        bf16_t* row = PW + (size_t)m * ODN;
#pragma unroll
        for (int hh = 0; hh < 10; ++hh) {
            bf16_t* q = row + hh * 128;
            const float x1 = bf2f(q[d1]), x2 = bf2f(q[d2]);
            const float rstd = rsqrtf(wave_sum(x1 * x1 + x2 * x2) * (1.f / 128.f) + EPS);
            const float y1 = x1 * rstd * (hh < 8 ? gq1 : gk1), y2 = x2 * rstd * (hh < 8 ? gq2 : gk2);
            if (!smp && hh >= 8) { float* co = p.out + OUT_CC + ((size_t)(((m >> 8) * 2 + i) * 2) * 256 + (m & 255)) * 256 + (hh - 8) * 128; co[d1] = y1; co[d2] = y2; }
            q[d1] = (bf16_t)f2bf(y1 * cs - y2 * sn); q[d2] = (bf16_t)f2bf(y2 * cs + y1 * sn);
        }
    }
}


#define XB_TMO      128
#define XB_XCNT(j)  (256  + 64 * (j))
#define XB_XSUB(j)  (1280 + 64 * (j))
#define XB_XGEN(j)  (2304 + 64 * (j))
#define XB_TOP      3328
#define XB_TOPGEN   3392
#define XCD_BAR_WORDS 3456
#define XB_SPIN_CAP (1u << 18)
__device__ __forceinline__ unsigned xb_ld(unsigned* p)              { return __hip_atomic_load(p, __ATOMIC_RELAXED, __HIP_MEMORY_SCOPE_AGENT); }
__device__ __forceinline__ unsigned xb_add(unsigned* p, unsigned v) { return __hip_atomic_fetch_add(p, v, __ATOMIC_RELAXED, __HIP_MEMORY_SCOPE_AGENT); }
__device__ __forceinline__ unsigned xb_xcc_id() { return (unsigned)__builtin_amdgcn_s_getreg((3 << 11) | 20) & 0xFu; }
#define XB_SPIN(cond, bar) do { unsigned _sp = 0; while (cond) { __builtin_amdgcn_s_sleep(1); \
    if ((++_sp & 255u) == 0u) { if (xb_ld(&(bar)[XB_TMO])) break; if (_sp > XB_SPIN_CAP) { atomicAdd(&(bar)[XB_TMO], 1u); break; } } } } while (0)
struct XcdBarrier { unsigned* bar; unsigned x; volatile LAS unsigned* st; };
__device__ __forceinline__ XcdBarrier xcd_barrier_post(unsigned* bar, volatile LAS unsigned* st) {
    XcdBarrier b; b.bar = bar; b.x = xb_xcc_id(); b.st = st;
    if (threadIdx.x == 0) (void)xb_add(&bar[XB_XCNT(b.x)], 1u);
    return b;
}
__device__ __forceinline__ void xcd_barrier_complete(unsigned* bar, unsigned x, unsigned& nloc, unsigned& nx) {
    const unsigned G = gridDim.x * gridDim.y * gridDim.z;
    unsigned sum, cnt, mine, sp = 0u;
    for (;;) {
        sum = 0u; cnt = 0u; mine = 0u;
#pragma unroll
        for (unsigned j = 0; j < 16; ++j) { const unsigned c = xb_ld(&bar[XB_XCNT(j)]); sum += c; cnt += (c > 0u) ? 1u : 0u; mine = (j == x) ? c : mine; }
        if (sum == G) break;
        __builtin_amdgcn_s_sleep(1);
        if ((++sp & 255u) == 0u) { if (xb_ld(&bar[XB_TMO])) break; if (sp > XB_SPIN_CAP) { atomicAdd(&bar[XB_TMO], 1u); break; } }
    }
    nloc = mine > 0u ? mine : 1u; nx = cnt > 0u ? cnt : 1u;
}
__device__ __forceinline__ void xcd_barrier(const XcdBarrier& b) {
    asm volatile("s_waitcnt vmcnt(0)" ::: "memory");
    __syncthreads();
    if (threadIdx.x == 0) {
        unsigned* bar = b.bar;
        __builtin_amdgcn_s_waitcnt(0);
        unsigned nloc = b.st[0], nx = b.st[1];
        if (nloc == 0u) { xcd_barrier_complete(bar, b.x, nloc, nx); b.st[0] = nloc; b.st[1] = nx; }
        const unsigned old = xb_add(&bar[XB_XSUB(b.x)], 1u);
        const unsigned gen = old / nloc;
        if (old + 1u == (gen + 1u) * nloc) {
            __builtin_amdgcn_fence(__ATOMIC_RELEASE, "agent");
            asm volatile("s_waitcnt vmcnt(0)" ::: "memory");
            const unsigned og = xb_add(&bar[XB_TOP], 1u);
            const unsigned tg = og / nx;
            if (og + 1u == (tg + 1u) * nx) xb_add(&bar[XB_TOPGEN], 1u);
            else XB_SPIN(xb_ld(&bar[XB_TOPGEN]) == tg, bar);
            __builtin_amdgcn_fence(__ATOMIC_ACQUIRE, "agent");
            xb_add(&bar[XB_XGEN(b.x)], 1u);
            asm volatile("s_waitcnt vmcnt(0)" ::: "memory");
        } else {
            XB_SPIN(xb_ld(&bar[XB_XGEN(b.x)]) == gen, bar);
            __builtin_amdgcn_fence(__ATOMIC_ACQUIRE, "agent");
            asm volatile("s_waitcnt vmcnt(0)" ::: "memory");
        }
    }
    __syncthreads();
}
__global__ void __launch_bounds__(512, 2) mega_fwd(Params p) {
    extern __shared__ __attribute__((aligned(16))) unsigned char lds_raw[];
    cg::grid_group grid = cg::this_grid();
#define GSYNC() do { asm volatile("s_waitcnt vmcnt(0) lgkmcnt(0)" ::: "memory"); grid.sync(); __builtin_amdgcn_fence(__ATOMIC_ACQUIRE, "agent"); asm volatile("s_waitcnt vmcnt(0)" ::: "memory"); } while (0)
    const int tid = threadIdx.x, lane = tid & 63, wave = __builtin_amdgcn_readfirstlane(tid >> 6);
    const int G = gridDim.x, bid = blockIdx.x, gw = bid * 8 + wave, NGW = G * 8;

    volatile LAS unsigned* misc = (volatile LAS unsigned*)((LAS unsigned char*)lds_raw + 131072 + 64);
    if (tid == 0) { misc[0] = 0u; misc[1] = 0u; }
    __syncthreads();
    (void)xcd_barrier_post((unsigned*)p.ws, misc);
    phase0(p, lds_raw, tid, lane, wave, bid, G);
#define XSYNC() do { XcdBarrier xb_; xb_.bar = (unsigned*)p.ws; xb_.x = xb_xcc_id(); xb_.st = (volatile LAS unsigned*)((LAS unsigned char*)lds_raw + 131072 + 64); xcd_barrier(xb_); } while (0)
    if (p.ws == nullptr) GSYNC();
    XSYNC();
#pragma unroll 1
    for (int l = 0; l < NLAYERS; ++l) {
        const bool even = (l & 1) == 0; const int i = l >> 1;
        size_t zo = 0; asm volatile("" : "+s"(zo)); unsigned char* ws = p.ws + zo; float* X = p.out + zo;
        bf16_t* H = (bf16_t*)(ws + WS_H); bf16_t* MIX = (bf16_t*)(ws + WS_MIX); bf16_t* DBUF = (bf16_t*)(ws + WS_D);
        const float* modl = (const float*)(ws + WS_MOD) + (size_t)l * 5 * 6144;
        bf16_t* X16 = (bf16_t*)(ws + WS_X16);
        if (l == 0) norm_phase(p.x_prompt, p.x_sample, nullptr, p.norm1_g, modl, 0, 1, H, gw, NGW, lane);
        else norm16_phase(X16, p.norm1_g + l * DM, modl, 0, 1, H, gw, NGW, lane);
        XSYNC();
        {
            const int N = even ? EVN : ODN;
            const bf16_t* Wt = even ? (const bf16_t*)(ws + WS_WEVIN) + (size_t)i * EVN * 1024 : (const bf16_t*)(ws + WS_WODIN) + (size_t)i * ODN * 1024;
            pg8::Gemm g{H, Wt, NTOK, N, DM}; pg8::StaticOrder S; S.init(NTOK, N, G, bid);
            pg8::EpiProj E;
            E.O = DBUF; E.ldc = even ? EVLD : ODN; E.npn_store = even ? 12 : 6;
            E.cache = X + (even ? OUT_CB : OUT_CC) + (size_t)i * 2 * 65536; E.pn_k = even ? 10 : 4; E.pn_lo = even ? 10 : 5; E.pn_hi = even ? 12 : 6;
            E.bg = (float*)(ws + WS_BG); E.pn_bg = even ? 12 : -1;
            pg8::gemm_phase<pg8::EpiProj>((LAS unsigned char*)lds_raw, g, S, E);
        }
        XSYNC();
        if (even) {
            e3a_phase(p, i, lds_raw, tid, lane, wave, bid, G);
            XSYNC();
            e3b_phase(p, lds_raw, tid, lane, wave, bid, G);
            XSYNC();
        } else {
            o3_phase(p, i, gw, NGW, lane);
            XSYNC();
        }
        mixer_phase(p, l, lds_raw, tid, lane, wave, bid, G);
        XSYNC();
        if (even) { e5_phase(p, i, gw, NGW, lane); XSYNC(); }
        {
            const bf16_t* Wt = even ? (const bf16_t*)(ws + WS_WEVOUT) + (size_t)i * 1024 * 1024 : (const bf16_t*)(ws + WS_WODOUT) + (size_t)i * 1024 * 1024;
            pg8::Gemm g{MIX, Wt, NTOK, DM, DM}; pg8::StaticOrder S; S.init(NTOK, DM, G, bid);
            pg8::EpiResid E; E.X = X16; E.gate = modl + 2 * 1024; E.xin_p = l == 0 ? p.x_prompt : nullptr; E.xin_s = l == 0 ? p.x_sample : nullptr;
            pg8::gemm_phase<pg8::EpiResid>((LAS unsigned char*)lds_raw, g, S, E);
        }
        XSYNC();
        norm16_phase(X16, p.norm2_g + l * DM, modl, 3, 4, H, gw, NGW, lane);
        XSYNC();
        {
            pg8::Gemm g{H, (const bf16_t*)(ws + WS_W1) + (size_t)l * DFF * DM, NTOK, DFF, DM}; pg8::StaticOrder S; S.init(NTOK, DFF, G, bid);
            pg8::EpiAct E; E.O = DBUF; E.ldc = DFF;
            pg8::gemm_phase<pg8::EpiAct>((LAS unsigned char*)lds_raw, g, S, E);
        }
        XSYNC();
        {
            pg8::Gemm g{DBUF, (const bf16_t*)(ws + WS_W2) + (size_t)l * DM * DFF, NTOK, DM, DFF}; pg8::StaticOrder S; S.init(NTOK, DM, G, bid);
            pg8::EpiResid E; E.X = X16; E.gate = modl + 5 * 1024; E.xin_p = nullptr; E.xin_s = nullptr;
            pg8::gemm_phase<pg8::EpiResid>((LAS unsigned char*)lds_raw, g, S, E);
        }
        XSYNC();
    }
    final_phase((const bf16_t*)(p.ws + WS_X16), p.out, p.final_g, gw, NGW, lane);
}

extern "C" void kernel_launch(void* const* d_in, const int* in_sizes, int n_in, void* d_out, int out_size, void* d_ws, size_t ws_size, hipStream_t stream) {
    static int grid = 0;
    if (grid == 0) {
        if (n_in != 25 || out_size != 25165824 || ws_size < WS_END) { fprintf(stderr, "kernel_launch: unexpected shapes: n_in %d out %d ws %zu\n", n_in, out_size, ws_size); grid = -1; return; }
        int dev = 0, cus = 0, per_cu = 0;
        hipGetDevice(&dev);
        hipDeviceGetAttribute(&cus, hipDeviceAttributeMultiprocessorCount, dev);
        if (hipFuncSetAttribute((const void*)mega_fwd, hipFuncAttributeMaxDynamicSharedMemorySize, LDS_BYTES) != hipSuccess) { fprintf(stderr, "kernel_launch: hipFuncSetAttribute failed\n"); grid = -1; return; }
        if (hipOccupancyMaxActiveBlocksPerMultiprocessor(&per_cu, (const void*)mega_fwd, 512, LDS_BYTES) != hipSuccess || per_cu < 1) { fprintf(stderr, "kernel_launch: occupancy query says %d\n", per_cu); per_cu = 1; }
        (void)hipGetLastError();
        grid = cus * 1;
    }
    if (grid < 0) return;
    if (hipMemsetAsync(d_ws, 0, 16384, stream) != hipSuccess) { fprintf(stderr, "kernel_launch: memset failed\n"); return; }
    Params p{};
    const float** pp = (const float**)&p;
    for (int k = 0; k < 25; ++k) pp[k] = (const float*)d_in[k];
    p.out = (float*)d_out; p.ws = (unsigned char*)d_ws;
    void* args[] = {&p};
    hipError_t e = hipLaunchCooperativeKernel((const void*)mega_fwd, dim3(grid), dim3(512), args, LDS_BYTES, stream);
    if (e != hipSuccess) fprintf(stderr, "kernel_launch: cooperative launch failed: %s (grid %d)\n", hipGetErrorString(e), grid);
}
```

```cpp
#include <hip/hip_runtime.h>
#include <hip/hip_cooperative_groups.h>
#include <cstdio>
#include <cstdint>
namespace cg = cooperative_groups;

#define LAS __attribute__((address_space(3)))
typedef unsigned short bf16_t;
typedef short bf16x8 __attribute__((ext_vector_type(8)));
typedef short s16x4 __attribute__((ext_vector_type(4)));
typedef float f32x4 __attribute__((ext_vector_type(4)));
typedef float f32x2 __attribute__((ext_vector_type(2)));
typedef float f32x16 __attribute__((ext_vector_type(16)));
typedef unsigned u32x4 __attribute__((ext_vector_type(4)));
typedef unsigned u32x2 __attribute__((ext_vector_type(2)));

constexpr int DM = 1024, NTOK = 12288, NPR = 4096, DFF = 4096;
constexpr int EVN = 3328, EVLD = 3072, ODN = 1536;
constexpr float EPS = 1e-6f;
constexpr float SCALE = 0.088388347648318440f;

constexpr size_t MiB = 1u << 20;
constexpr size_t WS_MOD = 1 * MiB;
constexpr size_t WS_WEVIN = 2 * MiB;
constexpr size_t WS_WEVOUT = 15 * MiB;
constexpr size_t WS_WODIN = 19 * MiB;
constexpr size_t WS_WODOUT = 25 * MiB;
constexpr size_t WS_W1 = 29 * MiB;
constexpr size_t WS_W2 = 61 * MiB;
constexpr size_t WS_CTXB = 93 * MiB;
constexpr size_t WS_CTXC = 97 * MiB;
constexpr size_t WS_H = 101 * MiB;
constexpr size_t WS_MIX = 125 * MiB;
constexpr size_t WS_BG = 149 * MiB;
constexpr size_t WS_BETA = 150 * MiB;
constexpr size_t WS_G = 150 * MiB + 512 * 1024;
constexpr size_t WS_GC = 151 * MiB;
constexpr size_t WS_D = 152 * MiB;
constexpr size_t WS_QN = 224 * MiB;
constexpr size_t WS_KN = 236 * MiB;
constexpr size_t WS_VN = 248 * MiB;
constexpr size_t WS_KNT = 260 * MiB;
constexpr size_t WS_U = 272 * MiB;
constexpr size_t WS_W = 296 * MiB;
constexpr size_t WS_QK = 320 * MiB;
constexpr size_t WS_ODN = 332 * MiB;
constexpr size_t WS_X16 = 356 * MiB;
constexpr size_t WS_END = 380 * MiB;

constexpr size_t OUT_STATE = 12582912, OUT_CB = 16777216, OUT_CC = 20971520;

constexpr int LDS_BYTES = 147456;
#ifndef NLAYERS
#define NLAYERS 4
#endif
#ifndef STOP_PH
#define STOP_PH 99
#endif

__device__ __forceinline__ unsigned cvt_pk(float lo, float hi) { unsigned r; asm volatile("v_cvt_pk_bf16_f32 %0, %1, %2" : "=v"(r) : "v"(lo), "v"(hi)); return r; }
__device__ __forceinline__ unsigned f2bf(float f) { return cvt_pk(f, 0.f) & 0xffffu; }
__device__ __forceinline__ float bf2f(unsigned h) { return __uint_as_float(h << 16); }
__device__ __forceinline__ float bflo(unsigned w) { return __uint_as_float(w << 16); }
__device__ __forceinline__ float bfhi(unsigned w) { return __uint_as_float(w & 0xffff0000u); }
__device__ __forceinline__ float wave_sum(float v) {
#pragma unroll
    for (int o = 1; o < 64; o <<= 1) v += __shfl_xor(v, o);
    return v;
}
__device__ __forceinline__ float silu_f(float x) { return x / (1.f + __expf(-x)); }
#define LDS_WAIT() asm volatile("s_waitcnt lgkmcnt(0)" ::: "memory")

namespace pg8 {
#define PG8_LAS __attribute__((address_space(3)))
constexpr int BM = 256, BK = 64, HALF = 128, HTB = HALF * BK * 2, STAGE_BYTES = 8 * HTB, NXCD = 8, WGM = 8;
__host__ __device__ __forceinline__ int lds_byte(int r, int c) { const int st = (r >> 4) * 2 + (c >> 5), rr = r & 15, cc = c & 31, ob = rr * 64 + cc * 2; return st * 1024 + (ob ^ (((ob >> 9) & 1) << 5)); }
__host__ __device__ __forceinline__ void stage_rc(int b, int& R, int& C) { const int st = b / 1024, sb = b % 1024, swz = sb ^ (((sb >> 9) & 1) << 5); R = (st >> 1) * 16 + swz / 64; C = (st & 1) * 32 + (swz % 64) / 2; }
__host__ __device__ __forceinline__ int perm32(int rho) { const int n = rho >> 4, i = rho & 15; return 8 * (i >> 2) + 4 * n + (i & 3); }
struct Unit { int pm, pn; };
struct Gemm { const bf16_t* A; const bf16_t* Bt; int M, N, K; };
struct StaticOrder {
    int nM, nN, nwg, G, c;
    __device__ void init(int M, int N, int G_, int c_) { nM = M / BM; nN = N / BM; nwg = nM * nN; G = G_; c = c_; }
    __device__ bool next(int i, Unit& u) const {
        const long L = (long)i * G + c; if (L >= nwg) return false;
        int wgid = (int)L; { const int q = nwg / NXCD, r = nwg % NXCD, xcd = wgid % NXCD, off = wgid / NXCD; wgid = (xcd < r ? xcd * (q + 1) : r * (q + 1) + (xcd - r) * q) + off; }
        const int nig = WGM * nN, gid = wgid / nig, fm = gid * WGM, gsz = (nM - fm) < WGM ? (nM - fm) : WGM;
        u.pm = fm + ((wgid % nig) % gsz); u.pn = (wgid % nig) / gsz; return true;
    }
};

struct EpiProj {
    static constexpr bool PERM = true;
    bf16_t* O; int ldc; int npn_store; float* cache; int pn_k, pn_lo, pn_hi; float* bg; int pn_bg;
    __device__ __forceinline__ void operator()(const f32x4 (&acc)[2][2][4][2], const Unit& u, int wr, int wc, int fr, int fq) const {
        const int row0 = u.pm * BM + wr * 64 + fr, colt = u.pn * BM + wc * 32 + 8 * fq;
        const bool st = u.pn < npn_store;
        const bool cf = (u.pm < 16) && (u.pn >= pn_lo) && (u.pn < pn_hi);
        const bool bgf = (u.pn == pn_bg) && (wc == 0) && (fq < 2);
        float* cb = cache + (size_t)(u.pm * 4 + (u.pn - pn_k)) * 65536;
#pragma unroll
        for (int ai = 0; ai < 2; ++ai)
#pragma unroll
            for (int m = 0; m < 4; ++m) {
                const int r = row0 + ai * HALF + m * 16, rt = wr * 64 + fr + ai * HALF + m * 16;
#pragma unroll
                for (int bj = 0; bj < 2; ++bj) {
                    const f32x4 v0 = acc[ai][bj][m][0], v1 = acc[ai][bj][m][1];
                    if (st) { u32x4 w; w.x = cvt_pk(v0[0], v0[1]); w.y = cvt_pk(v0[2], v0[3]); w.z = cvt_pk(v1[0], v1[1]); w.w = cvt_pk(v1[2], v1[3]);
                        *(u32x4*)(O + (size_t)r * ldc + colt + bj * HALF) = w; }
                    if (cf) { float* d = cb + rt * 256 + wc * 32 + 8 * fq + bj * HALF; *(f32x4*)d = v0; *(f32x4*)(d + 4) = v1; }
                    if (bgf && bj == 0) { float* d = bg + (size_t)r * 16 + 8 * fq; *(f32x4*)d = v0; *(f32x4*)(d + 4) = v1; }
                }
            }
    }
};
struct EpiAct {
    static constexpr bool PERM = true;
    bf16_t* O; int ldc;
    __device__ __forceinline__ void operator()(const f32x4 (&acc)[2][2][4][2], const Unit& u, int wr, int wc, int fr, int fq) const {
        const int row0 = u.pm * BM + wr * 64 + fr, colt = u.pn * BM + wc * 32 + 8 * fq;
#pragma unroll
        for (int ai = 0; ai < 2; ++ai)
#pragma unroll
            for (int m = 0; m < 4; ++m) {
                bf16_t* rowp = O + (size_t)(row0 + ai * HALF + m * 16) * ldc + colt;
#pragma unroll
                for (int bj = 0; bj < 2; ++bj) {
                    f32x4 v0 = acc[ai][bj][m][0], v1 = acc[ai][bj][m][1];
#pragma unroll
                    for (int j = 0; j < 4; ++j) { float a = fmaxf(v0[j], 0.f); v0[j] = a * a; float b = fmaxf(v1[j], 0.f); v1[j] = b * b; }
                    u32x4 w; w.x = cvt_pk(v0[0], v0[1]); w.y = cvt_pk(v0[2], v0[3]); w.z = cvt_pk(v1[0], v1[1]); w.w = cvt_pk(v1[2], v1[3]);
                    *(u32x4*)(rowp + bj * HALF) = w;
                }
            }
    }
};
struct EpiResid {
    static constexpr bool PERM = true;
    bf16_t* X; const float* gate; const float* xin_p; const float* xin_s;
    __device__ __forceinline__ void operator()(const f32x4 (&acc)[2][2][4][2], const Unit& u, int wr, int wc, int fr, int fq) const {
        const int row0 = u.pm * BM + wr * 64 + fr, col0 = u.pn * BM + wc * 32 + 8 * fq;
        const int cidx = u.pm < 16 ? 0 : 1 + ((u.pm - 16) >> 3);
        const float* srcb = xin_p ? (u.pm < 16 ? xin_p : xin_s - (size_t)NPR * DM) : nullptr;
        const float* gp = gate + cidx * 6144 + col0;
        f32x4 gv[2][2];
#pragma unroll
        for (int bj = 0; bj < 2; ++bj) { gv[bj][0] = *(const f32x4*)(gp + bj * HALF); gv[bj][1] = *(const f32x4*)(gp + bj * HALF + 4); }
#pragma unroll
        for (int ai = 0; ai < 2; ++ai)
#pragma unroll
            for (int m = 0; m < 4; ++m) {
                const size_t ro = (size_t)(row0 + ai * HALF + m * 16) * DM + col0;
#pragma unroll
                for (int bj = 0; bj < 2; ++bj) { f32x4 x0, x1;
                    if (srcb) { x0 = *(const f32x4*)(srcb + ro + bj * HALF); x1 = *(const f32x4*)(srcb + ro + bj * HALF + 4); }
                    else { const u32x4 xb = *(const u32x4*)(X + ro + bj * HALF); x0 = (f32x4){bflo(xb.x), bfhi(xb.x), bflo(xb.y), bfhi(xb.y)}; x1 = (f32x4){bflo(xb.z), bfhi(xb.z), bflo(xb.w), bfhi(xb.w)}; }
                    x0 = x0 + gv[bj][0] * acc[ai][bj][m][0]; x1 = x1 + gv[bj][1] * acc[ai][bj][m][1];
                    u32x4 w; w.x = cvt_pk(x0.x, x0.y); w.y = cvt_pk(x0.z, x0.w); w.z = cvt_pk(x1.x, x1.y); w.w = cvt_pk(x1.z, x1.w);
                    *(u32x4*)(X + ro + bj * HALF) = w; }
            }
    }
};

template <class Epi>
__device__ __forceinline__ void gemm_phase(PG8_LAS unsigned char* lds, const Gemm g, const StaticOrder& S, const Epi& E) {
    int tid = threadIdx.x; asm volatile("" : "+v"(tid));
    const int wid = __builtin_amdgcn_readfirstlane(tid >> 6), lane = tid & 63, wr = wid >> 2, wc = wid & 3, fr = lane & 15, fq = lane >> 4;
    const int K = g.K, nt = K / BK;
    unsigned voffA[2], voffB[2];
#pragma unroll
    for (int i = 0; i < 2; ++i) { int R, C; stage_rc(tid * 16 + i * 8192, R, C); const int Rb = Epi::PERM ? ((R & ~31) + perm32(R & 31)) : R;
        voffA[i] = (unsigned)(R * K + C) * 2u; voffB[i] = (unsigned)(Rb * K + C) * 2u; }
    const size_t kstep = (size_t)(BK * 2);
    const size_t hstep = (size_t)HALF * K * 2;
    const size_t tstep = 2 * hstep;
    const unsigned ldsw = (unsigned)wid * 1024u;
    const int aoff = lds_byte(wr * 64 + fr, fq * 8), boff = lds_byte(wc * 32 + fr, fq * 8);
#define PG8_SA(b, h) (((b) * 2 + (h)) * HTB)
#define PG8_SB(b, h) ((4 + (b) * 2 + (h)) * HTB)
#define PG8_STAGE(bufoff, gbase, voff) do { _Pragma("unroll") for (int _i = 0; _i < 2; ++_i) \
        __builtin_amdgcn_global_load_lds((const unsigned*)((const char*)(gbase) + (voff)[_i]), (PG8_LAS unsigned*)(lds + (bufoff) + ldsw + _i * 8192), 16, 0, 0); } while (0)
#define PG8_LDA(dst, b, h) do { _Pragma("unroll") for (int m = 0; m < 4; ++m) _Pragma("unroll") for (int k = 0; k < 2; ++k) dst[m][k] = *(const PG8_LAS bf16x8*)(lds + PG8_SA(b, h) + aoff + m * 2048 + k * 1024); } while (0)
#define PG8_LDB(dst, b, h) do { _Pragma("unroll") for (int n = 0; n < 2; ++n) _Pragma("unroll") for (int k = 0; k < 2; ++k) dst[n][k] = *(const PG8_LAS bf16x8*)(lds + PG8_SB(b, h) + boff + n * 2048 + k * 1024); } while (0)
#define PG8_MMA(ai, bj, At, Bt) do { __builtin_amdgcn_s_setprio(1); _Pragma("unroll") for (int m = 0; m < 4; ++m) _Pragma("unroll") for (int n = 0; n < 2; ++n) _Pragma("unroll") for (int k = 0; k < 2; ++k) \
        acc[ai][bj][m][n] = __builtin_amdgcn_mfma_f32_16x16x32_bf16(Bt[n][k], At[m][k], acc[ai][bj][m][n], 0, 0, 0); __builtin_amdgcn_s_setprio(0); } while (0)
#define PG8_WAIT_V(n) asm volatile("s_waitcnt vmcnt(" #n ")" ::: "memory")
#define PG8_WAIT_L(n) asm volatile("s_waitcnt lgkmcnt(" #n ")" ::: "memory")
#define PG8_BAR __builtin_amdgcn_s_barrier()
#define PG8_SCHED __builtin_amdgcn_sched_barrier(0)
    Unit cur, nxt; int ui = 0;
    if (!S.next(0, cur)) return;
    f32x4 acc[2][2][4][2];
#pragma unroll
    for (int a = 0; a < 2; ++a)
#pragma unroll
        for (int b = 0; b < 2; ++b)
#pragma unroll
            for (int m = 0; m < 4; ++m)
#pragma unroll
                for (int n = 0; n < 2; ++n) acc[a][b][m][n] = (f32x4){0.f, 0.f, 0.f, 0.f};
    bf16x8 At[4][2], B0[2][2], B1[2][2];
    const char* cA = (const char*)g.A + (size_t)cur.pm * tstep; const char* cB = (const char*)g.Bt + (size_t)cur.pn * tstep;
    PG8_STAGE(PG8_SB(0, 0), cB, voffB); PG8_STAGE(PG8_SA(0, 0), cA, voffA); PG8_STAGE(PG8_SB(0, 1), cB + hstep, voffB); PG8_STAGE(PG8_SA(0, 1), cA + hstep, voffA);
    if (wr == 1) PG8_BAR;
    PG8_WAIT_V(4); PG8_BAR;
    PG8_STAGE(PG8_SB(1, 0), cB + kstep, voffB); PG8_STAGE(PG8_SA(1, 0), cA + kstep, voffA); PG8_STAGE(PG8_SB(1, 1), cB + hstep + kstep, voffB);
    PG8_WAIT_V(6); PG8_BAR;
    for (;;) {
        const bool has_next = S.next(ui + 1, nxt);
        const char* nA = has_next ? (const char*)g.A + (size_t)nxt.pm * tstep : cA; const char* nB = has_next ? (const char*)g.Bt + (size_t)nxt.pn * tstep : cB;
        for (int t = 0; t < nt; t += 2) {
            const bool last = (t == nt - 2);
            const char* a1 = cA + (size_t)(t + 1) * kstep;
            const char* a2 = last ? nA : cA + (size_t)(t + 2) * kstep; const char* b2 = last ? nB : cB + (size_t)(t + 2) * kstep;
            const char* a3 = a2 + kstep; const char* b3 = b2 + kstep;
            PG8_LDB(B0, 0, 0); PG8_SCHED; PG8_LDA(At, 0, 0); PG8_STAGE(PG8_SA(1, 1), a1 + hstep, voffA);
            PG8_WAIT_L(8); PG8_BAR; PG8_WAIT_L(0); PG8_MMA(0, 0, At, B0); PG8_BAR; PG8_SCHED;
            PG8_LDB(B1, 0, 1); PG8_STAGE(PG8_SB(0, 0), b2, voffB);
            PG8_BAR; PG8_WAIT_L(0); PG8_MMA(0, 1, At, B1); PG8_BAR;
            PG8_LDA(At, 0, 1); PG8_STAGE(PG8_SA(0, 0), a2, voffA);
            PG8_BAR; PG8_WAIT_L(0); PG8_MMA(1, 0, At, B0); PG8_BAR; PG8_SCHED;
            PG8_STAGE(PG8_SB(0, 1), b2 + hstep, voffB);
            PG8_WAIT_V(6); PG8_BAR; PG8_MMA(1, 1, At, B1); PG8_BAR;
            PG8_LDB(B0, 1, 0); PG8_SCHED; PG8_LDA(At, 1, 0); PG8_STAGE(PG8_SA(0, 1), a2 + hstep, voffA);
            PG8_WAIT_L(8); PG8_BAR; PG8_WAIT_L(0); PG8_MMA(0, 0, At, B0); PG8_BAR; PG8_SCHED;
            PG8_LDB(B1, 1, 1); PG8_STAGE(PG8_SB(1, 0), b3, voffB);
            PG8_BAR; PG8_WAIT_L(0); PG8_MMA(0, 1, At, B1); PG8_BAR;
            PG8_LDA(At, 1, 1); PG8_STAGE(PG8_SA(1, 0), a3, voffA);
            PG8_BAR; PG8_WAIT_L(0); PG8_MMA(1, 0, At, B0); PG8_BAR; PG8_SCHED;
            PG8_STAGE(PG8_SB(1, 1), b3 + hstep, voffB);
            PG8_WAIT_V(6); PG8_BAR; PG8_MMA(1, 1, At, B1); PG8_BAR;
        }
        E(acc, cur, wr, wc, fr, fq);
        if (!has_next) break;
#pragma unroll
        for (int a = 0; a < 2; ++a)
#pragma unroll
            for (int b = 0; b < 2; ++b)
#pragma unroll
                for (int m = 0; m < 4; ++m)
#pragma unroll
                    for (int n = 0; n < 2; ++n) acc[a][b][m][n] = (f32x4){0.f, 0.f, 0.f, 0.f};
        cur = nxt; cA = nA; cB = nB; ++ui;
    }
    PG8_WAIT_V(0);
    if (wr == 0) PG8_BAR;
    PG8_BAR;
#undef PG8_SA
#undef PG8_SB
#undef PG8_STAGE
#undef PG8_LDA
#undef PG8_LDB
#undef PG8_MMA
#undef PG8_WAIT_V
#undef PG8_WAIT_L
#undef PG8_BAR
#undef PG8_SCHED
}
}

namespace att {
constexpr int D = 128, NW = 8, QBLK = 32, KVBLK = 64;
constexpr float THR = 8.f;
#ifndef ATT_SDEPTH
#define ATT_SDEPTH 1
#endif
constexpr size_t SHM_V = KVBLK * D * 2, SHM_K = KVBLK * D * 2, SHM_ATTN = 2 * SHM_V + 2 * SHM_K + NW * 64 * 4;
#define KSWZ(row, colB) ((row) * 256 + ((colB) ^ (((row) & 7) << 4)))
#define SBAR() __builtin_amdgcn_sched_barrier(0)
__device__ __forceinline__ int crow(int r, int hi) { return (r & 3) + 8 * (r >> 2) + 4 * hi; }
__device__ __forceinline__ void partialSM(f32x16& p0, f32x16& p1, float& m_reg, float& mn, float& alpha) {
    constexpr float C = SCALE * 1.4426950408889634f;
    float pmax = p0[0];
#pragma unroll
    for (int r = 1; r < 16; ++r) pmax = fmaxf(pmax, p0[r]);
#pragma unroll
    for (int r = 0; r < 16; ++r) pmax = fmaxf(pmax, p1[r]);
    { auto rr = __builtin_amdgcn_permlane32_swap(__float_as_uint(pmax), __float_as_uint(pmax), false, false);
      pmax = fmaxf(__uint_as_float(rr[0]), __uint_as_float(rr[1])); }
    if (__builtin_expect(__all(pmax - m_reg <= THR / SCALE), 1)) { mn = m_reg; alpha = 1.f; }
    else { mn = fmaxf(m_reg, pmax); alpha = __builtin_amdgcn_exp2f((m_reg - mn) * C); m_reg = mn; }
    float mnC = -mn * C;
#pragma unroll
    for (int r = 0; r < 16; ++r) p0[r] = fmaf(p0[r], C, mnC);
#pragma unroll
    for (int r = 0; r < 16; ++r) p1[r] = fmaf(p1[r], C, mnC);
#pragma unroll
    for (int r = 0; r < 16; ++r) p0[r] = __builtin_amdgcn_exp2f(p0[r]);
}
__device__ __forceinline__ void finishSM(f32x16& p0, f32x16& p1, float alpha, float& l_reg, bf16x8& pa0, bf16x8& pa1, bf16x8& pa2, bf16x8& pa3) {
#pragma unroll
    for (int r = 0; r < 16; ++r) p1[r] = __builtin_amdgcn_exp2f(p1[r]);
    float ps = 0;
#pragma unroll
    for (int r = 0; r < 16; ++r) ps += p0[r];
#pragma unroll
    for (int r = 0; r < 16; ++r) ps += p1[r];
    { auto rr = __builtin_amdgcn_permlane32_swap(__float_as_uint(ps), __float_as_uint(ps), false, false);
      ps = __uint_as_float(rr[0]) + __uint_as_float(rr[1]); }
    l_reg = l_reg * alpha + ps;
#define PK4(P, BASE, OUT) do { unsigned a0 = cvt_pk(P[BASE + 0], P[BASE + 1]), a1 = cvt_pk(P[BASE + 2], P[BASE + 3]);   \
    unsigned b0 = cvt_pk(P[BASE + 4], P[BASE + 5]), b1 = cvt_pk(P[BASE + 6], P[BASE + 7]);                              \
    auto r0 = __builtin_amdgcn_permlane32_swap(a0, b0, false, false); auto r1 = __builtin_amdgcn_permlane32_swap(a1, b1, false, false); \
    u32x4 w = {r0[0], r1[0], r0[1], r1[1]}; OUT = *reinterpret_cast<bf16x8*>(&w); } while (0)
    PK4(p0, 0, pa0); PK4(p0, 8, pa1); PK4(p1, 0, pa2); PK4(p1, 8, pa3);
#undef PK4
}
__device__ __forceinline__ void qkt(f32x16& p0, f32x16& p1, const bf16_t* Ks, const bf16x8* qr, int r32, int hi) {
    p0 = f32x16{}; p1 = f32x16{};
#pragma unroll
    for (int d0 = 0; d0 < 8; ++d0) { int cb = (d0 * 16 + hi * 8) * 2;
        bf16x8 b0 = *reinterpret_cast<const bf16x8*>((const char*)Ks + KSWZ(r32, cb));
        bf16x8 b1 = *reinterpret_cast<const bf16x8*>((const char*)Ks + KSWZ(32 + r32, cb));
        p0 = __builtin_amdgcn_mfma_f32_32x32x16_bf16(b0, qr[d0], p0, 0, 0, 0);
        p1 = __builtin_amdgcn_mfma_f32_32x32x16_bf16(b1, qr[d0], p1, 0, 0, 0); }
}
template <bool BAND> __device__ __forceinline__ void maskp(f32x16& p0, f32x16& p1, int t, int nct, int qp, int hi) {
    if constexpr (BAND) {
        if (t >= nct) {
            const int kb = (t - nct) * 64;
#pragma unroll
            for (int r = 0; r < 16; ++r) { const int kp = kb + crow(r, hi); int dd = qp - kp; dd = dd < 0 ? -dd : dd; if (dd > 128) p0[r] = -1e30f;
                int d2 = qp - kp - 32; d2 = d2 < 0 ? -d2 : d2; if (d2 > 128) p1[r] = -1e30f; }
        }
    }
}
__device__ __forceinline__ int v_st(int k, int c) { const int kk = (k & ~0xC) | ((k & 4) << 1) | ((k & 8) >> 1); return ((kk >> 3) * 4 + (c >> 5)) * 512 + ((kk & 7) * 32 + (c & 31)) * 2; }
__device__ __forceinline__ int v_rd_base(int lane) { return ((lane & 3) << 3) | (((lane >> 2) & 3) << 6) | (((lane >> 4) & 1) << 5) | (((lane >> 5) & 1) << 8); }
constexpr int v_rd_off(int d0, int ks, int half) { return d0 * 512 + ks * 4096 + half * 2048; }
template <int OFF> __device__ __forceinline__ s16x4 tr_read(int vb) {
    s16x4 r; asm volatile("ds_read_b64_tr_b16 %0, %1 offset:%2" : "=&v"(r) : "v"(vb), "i"(OFF) : "memory"); return r;
}
template <int D0> __device__ __forceinline__ void pv_one(f32x16& od, int vb, bf16x8 pa0, bf16x8 pa1, bf16x8 pa2, bf16x8 pa3) {
    const s16x4 l0 = tr_read<v_rd_off(D0, 0, 0)>(vb), h0 = tr_read<v_rd_off(D0, 0, 1)>(vb), l1 = tr_read<v_rd_off(D0, 1, 0)>(vb), h1 = tr_read<v_rd_off(D0, 1, 1)>(vb);
    const s16x4 l2 = tr_read<v_rd_off(D0, 2, 0)>(vb), h2 = tr_read<v_rd_off(D0, 2, 1)>(vb), l3 = tr_read<v_rd_off(D0, 3, 0)>(vb), h3 = tr_read<v_rd_off(D0, 3, 1)>(vb);
    asm volatile("s_waitcnt lgkmcnt(0)" ::: "memory"); SBAR();
#define PK(L, H) (bf16x8){L[0], L[1], L[2], L[3], H[0], H[1], H[2], H[3]}
    od = __builtin_amdgcn_mfma_f32_32x32x16_bf16(pa0, PK(l0, h0), od, 0, 0, 0);
    od = __builtin_amdgcn_mfma_f32_32x32x16_bf16(pa1, PK(l1, h1), od, 0, 0, 0);
    od = __builtin_amdgcn_mfma_f32_32x32x16_bf16(pa2, PK(l2, h2), od, 0, 0, 0);
    od = __builtin_amdgcn_mfma_f32_32x32x16_bf16(pa3, PK(l3, h3), od, 0, 0, 0);
#undef PK
}
__device__ __forceinline__ void pv_d0(f32x16* o, int vb, bf16x8 pa0, bf16x8 pa1, bf16x8 pa2, bf16x8 pa3) {
    pv_one<0>(o[0], vb, pa0, pa1, pa2, pa3); pv_one<1>(o[1], vb, pa0, pa1, pa2, pa3); pv_one<2>(o[2], vb, pa0, pa1, pa2, pa3); pv_one<3>(o[3], vb, pa0, pa1, pa2, pa3);
}

template <bool BAND>
__device__ __forceinline__ void attn_body(const bf16_t* __restrict__ Qb, int ldq, const bf16_t* __restrict__ Kc, const bf16_t* __restrict__ Vc, int ldc, int nct,
                                          const bf16_t* __restrict__ Kl, const bf16_t* __restrict__ Vl, int ldl, int NT,
                                          bf16_t* __restrict__ Ob, int ldo, float m_init, float l_init, int qoff, char* lds) {
    int tid = threadIdx.x; asm volatile("" : "+v"(tid));
    const int wid = tid >> 6, lane = tid & 63, r32 = lane & 31, hi = lane >> 5;
    bf16_t* V_lds = (bf16_t*)lds; bf16_t* K_lds = (bf16_t*)(lds + 2 * SHM_V);
    float* wsl = (float*)(lds + 2 * SHM_V + 2 * SHM_K) + wid * 64; float* li_l = wsl; float* al_l = wsl + 32;
    float m_reg = m_init, l_reg = l_init; f32x16 o[4] = {}; bf16x8 qr[8];
    const bf16_t* Qw = Qb + (long)(wid * QBLK + r32) * ldq + hi * 8;
#pragma unroll
    for (int d0 = 0; d0 < 8; ++d0) qr[d0] = *reinterpret_cast<const bf16x8*>(Qw + d0 * 16);
    const int sr = tid >> 4, sc = (tid & 15) * 8, vst0 = v_st(sr, sc), vst1 = v_st(32 + sr, sc);
    const int vb0 = (int)(uintptr_t)V_lds + v_rd_base(lane);
    const int qp = qoff + wid * QBLK + r32;
    const int offc = sr * ldc + sc, offl = sr * ldl + sc;
    constexpr int SDEPTH = ATT_SDEPTH;
    struct { bf16x8 vs0, vs1, ks0, ks1; } sr_[SDEPTH];
#define SLOAD(i, t) do { const bool _c = (t) < nct; const bf16_t* _k = _c ? Kc + (long)(t) * 64 * ldc : Kl + (long)((t) - nct) * 64 * ldl; \
    const bf16_t* _v = _c ? Vc + (long)(t) * 64 * ldc : Vl + (long)((t) - nct) * 64 * ldl; const int _o = _c ? offc : offl; const int _h = (_c ? ldc : ldl) * 32; \
    sr_[i].vs0 = *reinterpret_cast<const bf16x8*>(_v + _o); sr_[i].vs1 = *reinterpret_cast<const bf16x8*>(_v + _o + _h); \
    sr_[i].ks0 = *reinterpret_cast<const bf16x8*>(_k + _o); sr_[i].ks1 = *reinterpret_cast<const bf16x8*>(_k + _o + _h); } while (0)
#define SWRITE(b, i) do { *(bf16x8*)((char*)V_lds + (b) * SHM_V + vst0) = sr_[i].vs0;          \
    *(bf16x8*)((char*)V_lds + (b) * SHM_V + vst1) = sr_[i].vs1; int kc = sc * 2;               \
    *(bf16x8*)((char*)K_lds + (b) * SHM_K + KSWZ(sr, kc)) = sr_[i].ks0;                       \
    *(bf16x8*)((char*)K_lds + (b) * SHM_K + KSWZ(32 + sr, kc)) = sr_[i].ks1; } while (0)
#define SWAIT() do { if constexpr (SDEPTH == 2) asm volatile("s_waitcnt vmcnt(4)" ::: "memory"); else asm volatile("s_waitcnt vmcnt(0)" ::: "memory"); } while (0)
#define RESC(a) do { if (__any((a) < 1.f)) { if (hi == 0) al_l[r32] = (a); asm volatile("s_waitcnt lgkmcnt(0)" ::: "memory"); \
    _Pragma("unroll") for (int d = 0; d < 4; ++d) _Pragma("unroll") for (int r = 0; r < 16; ++r) o[d][r] *= al_l[crow(r, hi)]; } } while (0)
    f32x16 pA0, pA1, pB0, pB1; float mnA, mnB, alA, alB; bf16x8 pa0, pa1, pa2, pa3;
    constexpr int SE = 0, SO = SDEPTH - 1;
    SLOAD(SE, 0); asm volatile("s_waitcnt vmcnt(0)" ::: "memory"); SWRITE(0, SE); __syncthreads();
    qkt(pA0, pA1, K_lds, qr, r32, hi); maskp<BAND>(pA0, pA1, 0, nct, qp, hi); partialSM(pA0, pA1, m_reg, mnA, alA);
    SLOAD(SO, 1); if constexpr (SDEPTH == 2) { if (2 < NT) SLOAD(SE, 2); }
    SWAIT(); SWRITE(1, SO); __syncthreads();
    for (int j = 1; j + 1 < NT; j += 2) {
        SBAR(); qkt(pB0, pB1, (bf16_t*)((char*)K_lds + SHM_K), qr, r32, hi); maskp<BAND>(pB0, pB1, j, nct, qp, hi);
        finishSM(pA0, pA1, alA, l_reg, pa0, pa1, pa2, pa3); SBAR();
        SLOAD(SO, j + SDEPTH); SBAR();
        pv_d0(o, vb0, pa0, pa1, pa2, pa3); partialSM(pB0, pB1, m_reg, mnB, alB);
        __syncthreads(); SWAIT(); SWRITE(0, SE);
        RESC(alB); __syncthreads();
        SBAR(); qkt(pA0, pA1, K_lds, qr, r32, hi); maskp<BAND>(pA0, pA1, j + 1, nct, qp, hi);
        finishSM(pB0, pB1, alB, l_reg, pa0, pa1, pa2, pa3); SBAR();
        if (SDEPTH == 1 || j + 3 < NT) SLOAD(SE, j + 1 + SDEPTH); SBAR();
        pv_d0(o, vb0 + (int)SHM_V, pa0, pa1, pa2, pa3); partialSM(pA0, pA1, m_reg, mnA, alA);
        __syncthreads(); SWAIT(); SWRITE(1, SO);
        RESC(alA); __syncthreads();
    }
    SBAR(); qkt(pB0, pB1, (bf16_t*)((char*)K_lds + SHM_K), qr, r32, hi); maskp<BAND>(pB0, pB1, NT - 1, nct, qp, hi);
    finishSM(pA0, pA1, alA, l_reg, pa0, pa1, pa2, pa3); SBAR();
    pv_d0(o, vb0, pa0, pa1, pa2, pa3); partialSM(pB0, pB1, m_reg, mnB, alB);
    __syncthreads(); RESC(alB);
    finishSM(pB0, pB1, alB, l_reg, pa0, pa1, pa2, pa3); SBAR();
    pv_d0(o, vb0 + (int)SHM_V, pa0, pa1, pa2, pa3);
    if (hi == 0) li_l[r32] = l_reg; asm volatile("s_waitcnt lgkmcnt(0)" ::: "memory");
    float rli[16];
#pragma unroll
    for (int r = 0; r < 16; ++r) rli[r] = __builtin_amdgcn_rcpf(li_l[crow(r, hi)]);
    bf16_t* Ow = Ob + (long)(wid * QBLK) * ldo;
#pragma unroll
    for (int r = 0; r < 16; ++r) { int orow = crow(r, hi);
#pragma unroll
        for (int d0 = 0; d0 < 4; ++d0) Ow[(long)orow * ldo + d0 * 32 + r32] = (bf16_t)f2bf(o[d0][r] * rli[r]); }
    __syncthreads();
#undef SLOAD
#undef SWRITE
#undef SWAIT
#undef RESC
}
}

struct Params {
    const float *x_prompt, *x_sample, *state_a, *cache_b, *cache_c, *c, *c_ctx, *ada_w, *ada_b, *norm1_g, *norm2_g, *final_g,
                *mlp_w1, *mlp_w2, *ev_w_in, *a_conv, *a_log, *a_dt_bias, *a_norm_g, *b_sink, *ev_w_out, *od_w_in, *c_qnorm_g, *c_knorm_g, *od_w_out;
    float* out; unsigned char* ws;
};

template <int MAP>
__device__ __forceinline__ void transpose_item(const float* W, int K, int Nsrc, bf16_t* WT, int nblk, LAS float* scr, int item, int lane) {
    const int kb = item / nblk, nb = item % nblk, k0 = 64 * kb, n0 = 32 * nb;
    const int nd = n0 + (lane & 31);
    int src = nd;
    if (MAP == 1) src = nd < 2048 ? nd : (nd < 3072 ? nd + 16 : (nd < 3088 ? nd - 1024 : -1));
    float tv[32];
#pragma unroll
    for (int i = 0; i < 32; ++i) { const int kk = 2 * i + (lane >> 5); const float wv_ = W[(size_t)(k0 + kk) * Nsrc + (src >= 0 ? src : 0)]; tv[i] = src >= 0 ? wv_ : 0.f; }
#pragma unroll
    for (int i = 0; i < 32; ++i) { const int kk = 2 * i + (lane >> 5); scr[kk * 33 + (lane & 31)] = tv[i]; }
    LDS_WAIT();
    const int c = lane & 7;
#pragma unroll
    for (int j = 0; j < 4; ++j) { const int n = (lane >> 3) + 8 * j; const LAS float* s = scr + (8 * c) * 33 + n;
        u32x4 o; o.x = cvt_pk(s[0 * 33], s[1 * 33]); o.y = cvt_pk(s[2 * 33], s[3 * 33]); o.z = cvt_pk(s[4 * 33], s[5 * 33]); o.w = cvt_pk(s[6 * 33], s[7 * 33]);
        *(u32x4*)(WT + (size_t)(n0 + n) * K + k0 + 8 * c) = o; }
    LDS_WAIT();
}

__device__ __forceinline__ void phase0(const Params& p, unsigned char* lds_raw, int tid, int lane, int wave, int bid, int G) {
    asm volatile("" : "+s"(bid), "+s"(G), "+s"(wave));
    size_t zo_ = 0; asm volatile("" : "+s"(zo_)); unsigned char* ws_ = p.ws + zo_;
    asm volatile("" : "+v"(tid), "+v"(lane));
    LAS unsigned char* lds = (LAS unsigned char*)lds_raw;
    LAS float* SIL = (LAS float*)(lds + 73728);
    LAS float* RED = (LAS float*)(lds + 94208);
    for (int i = tid; i < 5 * 1024; i += 512) { const int c = i >> 10, k = i & 1023; const float v = c == 0 ? p.c_ctx[k] : p.c[(c - 1) * 1024 + k]; SIL[i] = silu_f(v); }
    __syncthreads();
    float* MOD = (float*)(ws_ + WS_MOD);
    for (int it = bid; it < 768; it += G) {
        const int l = it / 192, cgp = it % 192;
        const int col = lane & 31, kh = lane >> 5;
        const float* w = p.ada_w + (size_t)l * 1024 * 6144 + cgp * 32 + col;
        float a0 = 0.f, a1 = 0.f, a2 = 0.f, a3 = 0.f, a4 = 0.f;
        const int kb = wave * 128 + kh;
#pragma unroll 32
        for (int k2 = 0; k2 < 64; ++k2) { const int k = kb + 2 * k2; const float wv = w[(size_t)k * 6144];
            a0 += SIL[k] * wv; a1 += SIL[1024 + k] * wv; a2 += SIL[2048 + k] * wv; a3 += SIL[3072 + k] * wv; a4 += SIL[4096 + k] * wv; }
        a0 += __shfl_xor(a0, 32); a1 += __shfl_xor(a1, 32); a2 += __shfl_xor(a2, 32); a3 += __shfl_xor(a3, 32); a4 += __shfl_xor(a4, 32);
        if (kh == 0) { RED[(wave * 5 + 0) * 32 + col] = a0; RED[(wave * 5 + 1) * 32 + col] = a1; RED[(wave * 5 + 2) * 32 + col] = a2; RED[(wave * 5 + 3) * 32 + col] = a3; RED[(wave * 5 + 4) * 32 + col] = a4; }
        __syncthreads();
        if (tid < 160) { const int c = tid >> 5, cc = tid & 31; float sacc = 0.f;
#pragma unroll
            for (int w8 = 0; w8 < 8; ++w8) sacc += RED[(w8 * 5 + c) * 32 + cc];
            MOD[(l * 5 + c) * 6144 + cgp * 32 + cc] = sacc + p.ada_b[l * 6144 + cgp * 32 + cc]; }
        __syncthreads();
    }
    LAS float* scr = (LAS float*)(lds + wave * 9216);
    const int gw = bid * 8 + wave, NGW = G * 8;
    constexpr int I_EVIN = 16 * 104, I_SQ = 16 * 32, I_ODIN = 16 * 48, I_W1 = 16 * 128, I_W2 = 64 * 32;
    constexpr int NITEMS = 2 * I_EVIN + 2 * I_SQ + 2 * I_ODIN + 2 * I_SQ + 4 * I_W1 + 4 * I_W2;
    for (int it = gw; it < NITEMS; it += NGW) {
        int r = it;
        if (r < 2 * I_EVIN) { const int i = r / I_EVIN; transpose_item<1>(p.ev_w_in + (size_t)i * 1024 * 3088, 1024, 3088, (bf16_t*)(ws_ + WS_WEVIN) + (size_t)i * EVN * 1024, 104, scr, r % I_EVIN, lane); continue; } r -= 2 * I_EVIN;
        if (r < 2 * I_SQ) { const int i = r / I_SQ; transpose_item<0>(p.ev_w_out + (size_t)i * 1024 * 1024, 1024, 1024, (bf16_t*)(ws_ + WS_WEVOUT) + (size_t)i * 1024 * 1024, 32, scr, r % I_SQ, lane); continue; } r -= 2 * I_SQ;
        if (r < 2 * I_ODIN) { const int i = r / I_ODIN; transpose_item<0>(p.od_w_in + (size_t)i * 1024 * 1536, 1024, 1536, (bf16_t*)(ws_ + WS_WODIN) + (size_t)i * 1536 * 1024, 48, scr, r % I_ODIN, lane); continue; } r -= 2 * I_ODIN;
        if (r < 2 * I_SQ) { const int i = r / I_SQ; transpose_item<0>(p.od_w_out + (size_t)i * 1024 * 1024, 1024, 1024, (bf16_t*)(ws_ + WS_WODOUT) + (size_t)i * 1024 * 1024, 32, scr, r % I_SQ, lane); continue; } r -= 2 * I_SQ;
        if (r < 4 * I_W1) { const int i = r / I_W1; transpose_item<0>(p.mlp_w1 + (size_t)i * 1024 * 4096, 1024, 4096, (bf16_t*)(ws_ + WS_W1) + (size_t)i * 4096 * 1024, 128, scr, r % I_W1, lane); continue; } r -= 4 * I_W1;
        { const int i = r / I_W2; transpose_item<0>(p.mlp_w2 + (size_t)i * 4096 * 1024, 4096, 1024, (bf16_t*)(ws_ + WS_W2) + (size_t)i * 1024 * 4096, 32, scr, r % I_W2, lane); }
    }
    const int NC8 = 262144;
    for (int i = bid * 512 + tid; i < 2 * NC8; i += G * 512) {
        const bool isb = i < NC8; const int j = isb ? i : i - NC8;
        const float* s = (isb ? p.cache_b : p.cache_c) + (size_t)j * 8;
        const f32x4 a = *(const f32x4*)s, b = *(const f32x4*)(s + 4);
        u32x4 o; o.x = cvt_pk(a[0], a[1]); o.y = cvt_pk(a[2], a[3]); o.z = cvt_pk(b[0], b[1]); o.w = cvt_pk(b[2], b[3]);
        *(u32x4*)((bf16_t*)(ws_ + (isb ? WS_CTXB : WS_CTXC)) + (size_t)j * 8) = o;
    }
}

__device__ __forceinline__ void norm_phase(const float* xp, const float* xs, float* Xcopy, const float* g, const float* modl, int shift_chunk, int scale_chunk,
                                           bf16_t* H, int gw, int NGW, int lane) {
    asm volatile("" : "+s"(gw), "+s"(NGW));
    asm volatile("" : "+v"(lane));
    for (int m = gw; m < NTOK; m += NGW) {
        const float* src = m < NPR ? xp + (size_t)m * DM : xs + (size_t)(m - NPR) * DM;
        const int cidx = m < NPR ? 0 : 1 + ((m - NPR) >> 11);
        const f32x4* xr = (const f32x4*)src + lane;
        f32x4 v[4]; float s = 0.f;
#pragma unroll
        for (int j = 0; j < 4; ++j) { v[j] = xr[64 * j]; s += (v[j].x * v[j].x + v[j].y * v[j].y) + (v[j].z * v[j].z + v[j].w * v[j].w); }
        const float rstd = rsqrtf(wave_sum(s) * (1.f / DM) + EPS);
        const f32x4* gp = (const f32x4*)g + lane;
        const f32x4* shp = (const f32x4*)(modl + cidx * 6144 + shift_chunk * 1024) + lane;
        const f32x4* scp = (const f32x4*)(modl + cidx * 6144 + scale_chunk * 1024) + lane;
        u32x2* o8 = (u32x2*)(H + (size_t)m * DM) + lane;
#pragma unroll
        for (int j = 0; j < 4; ++j) {
            const f32x4 gg = gp[64 * j], sh = shp[64 * j], sc = scp[64 * j];
            const f32x4 h = v[j] * rstd * gg * (sc + 1.f) + sh;
            u32x2 w; w.x = cvt_pk(h.x, h.y); w.y = cvt_pk(h.z, h.w); o8[64 * j] = w;
            if (Xcopy) ((f32x4*)(Xcopy + (size_t)m * DM) + lane)[64 * j] = v[j];
        }
    }
}
__device__ __forceinline__ void norm16_phase(const bf16_t* X16, const float* g, const float* modl, int shift_chunk, int scale_chunk, bf16_t* H, int gw, int NGW, int lane) {
    asm volatile("" : "+s"(gw), "+s"(NGW));
    asm volatile("" : "+v"(lane));
    for (int m = gw; m < NTOK; m += NGW) {
        const int cidx = m < NPR ? 0 : 1 + ((m - NPR) >> 11);
        const bf16_t* xr = X16 + (size_t)m * DM + lane * 8;
        const u32x4 r0 = *(const u32x4*)xr, r1 = *(const u32x4*)(xr + 512);
        float v[16];
        v[0] = bflo(r0.x); v[1] = bfhi(r0.x); v[2] = bflo(r0.y); v[3] = bfhi(r0.y); v[4] = bflo(r0.z); v[5] = bfhi(r0.z); v[6] = bflo(r0.w); v[7] = bfhi(r0.w);
        v[8] = bflo(r1.x); v[9] = bfhi(r1.x); v[10] = bflo(r1.y); v[11] = bfhi(r1.y); v[12] = bflo(r1.z); v[13] = bfhi(r1.z); v[14] = bflo(r1.w); v[15] = bfhi(r1.w);
        float sq = 0.f;
#pragma unroll
        for (int j = 0; j < 16; ++j) sq += v[j] * v[j];
        const float rstd = rsqrtf(wave_sum(sq) * (1.f / DM) + EPS);
        const float* gp = g + lane * 8; const float* shp = modl + cidx * 6144 + shift_chunk * 1024 + lane * 8; const float* scp = modl + cidx * 6144 + scale_chunk * 1024 + lane * 8;
        u32x4 o[2];
#pragma unroll
        for (int hh = 0; hh < 2; ++hh) {
            const f32x4 ga = *(const f32x4*)(gp + 512 * hh), gb = *(const f32x4*)(gp + 512 * hh + 4), sa = *(const f32x4*)(shp + 512 * hh), sb = *(const f32x4*)(shp + 512 * hh + 4);
            const f32x4 ca = *(const f32x4*)(scp + 512 * hh), cb = *(const f32x4*)(scp + 512 * hh + 4);
            float h8[8];
#pragma unroll
            for (int j = 0; j < 4; ++j) { h8[j] = v[8 * hh + j] * rstd * ga[j] * (ca[j] + 1.f) + sa[j]; h8[4 + j] = v[8 * hh + 4 + j] * rstd * gb[j] * (cb[j] + 1.f) + sb[j]; }
            o[hh].x = cvt_pk(h8[0], h8[1]); o[hh].y = cvt_pk(h8[2], h8[3]); o[hh].z = cvt_pk(h8[4], h8[5]); o[hh].w = cvt_pk(h8[6], h8[7]);
        }
        bf16_t* hr = H + (size_t)m * DM + lane * 8; *(u32x4*)hr = o[0]; *(u32x4*)(hr + 512) = o[1];
    }
}
__device__ __forceinline__ void final_phase(const bf16_t* X16, float* Y, const float* g, int gw, int NGW, int lane) {
    asm volatile("" : "+s"(gw), "+s"(NGW));
    asm volatile("" : "+v"(lane));
    for (int m = gw; m < NTOK; m += NGW) {
        const bf16_t* xr = X16 + (size_t)m * DM + lane * 8;
        const u32x4 r0 = *(const u32x4*)xr, r1 = *(const u32x4*)(xr + 512);
        float v[16];
        v[0] = bflo(r0.x); v[1] = bfhi(r0.x); v[2] = bflo(r0.y); v[3] = bfhi(r0.y); v[4] = bflo(r0.z); v[5] = bfhi(r0.z); v[6] = bflo(r0.w); v[7] = bfhi(r0.w);
        v[8] = bflo(r1.x); v[9] = bfhi(r1.x); v[10] = bflo(r1.y); v[11] = bfhi(r1.y); v[12] = bflo(r1.z); v[13] = bfhi(r1.z); v[14] = bflo(r1.w); v[15] = bfhi(r1.w);
        float sq = 0.f;
#pragma unroll
        for (int j = 0; j < 16; ++j) sq += v[j] * v[j];
        const float rstd = rsqrtf(wave_sum(sq) * (1.f / DM) + EPS);
        float* yr = Y + (size_t)m * DM + lane * 8;
#pragma unroll
        for (int hh = 0; hh < 2; ++hh) { const f32x4 ga = *(const f32x4*)(g + lane * 8 + 512 * hh), gb = *(const f32x4*)(g + lane * 8 + 512 * hh + 4);
            *(f32x4*)(yr + 512 * hh) = (f32x4){v[8 * hh] * rstd * ga[0], v[8 * hh + 1] * rstd * ga[1], v[8 * hh + 2] * rstd * ga[2], v[8 * hh + 3] * rstd * ga[3]};
            *(f32x4*)(yr + 512 * hh + 4) = (f32x4){v[8 * hh + 4] * rstd * gb[0], v[8 * hh + 5] * rstd * gb[1], v[8 * hh + 6] * rstd * gb[2], v[8 * hh + 7] * rstd * gb[3]}; }
    }
}

__device__ __forceinline__ void e3a_phase(const Params& p, int i, unsigned char* lds_raw, int tid, int lane, int wave, int bid, int G) {
    asm volatile("" : "+s"(bid), "+s"(G), "+s"(wave));
    size_t zo_ = 0; asm volatile("" : "+s"(zo_)); unsigned char* ws_ = p.ws + zo_;
    asm volatile("" : "+v"(tid), "+v"(lane));
    const bf16_t* PROJ = (const bf16_t*)(ws_ + WS_D);
    bf16_t* QN = (bf16_t*)(ws_ + WS_QN); bf16_t* KN = (bf16_t*)(ws_ + WS_KN); bf16_t* VN = (bf16_t*)(ws_ + WS_VN); bf16_t* KNT = (bf16_t*)(ws_ + WS_KNT);
    const float* BG = (const float*)(ws_ + WS_BG); float* BETA = (float*)(ws_ + WS_BETA); float* GG = (float*)(ws_ + WS_G);
    LAS float* QF = (LAS float*)lds_raw;
    LAS float* KF = QF + 64 * 132;
    const float* convw = p.a_conv + (size_t)i * 3 * 1536;
    for (int it = bid; it < 768; it += G) {
        const int tb = it >> 2, h = it & 3, m0 = tb * 64;
        const bool first = tb < 64 ? ((tb & 3) == 0) : (((tb - 64) & 31) == 0);
        const bool lastb = tb < 64 ? ((tb & 3) == 3) : (((tb - 64) & 31) == 31);
        const int d = tid & 127, rg = tid >> 7, c0 = rg * 16;
#pragma unroll
        for (int part = 0; part < 3; ++part) {
            const int col = part * 512 + h * 128 + d;
            const float w0 = convw[col], w1 = convw[1536 + col], w2 = convw[3072 + col];
            const bf16_t* src = PROJ + (size_t)m0 * EVLD + col;
            const bool zp = (c0 == 0 && first);
            const float xp_ld = bf2f(src[(long)(zp ? c0 : c0 - 1) * EVLD]);
            float xprev = zp ? 0.f : xp_ld;
            float xcur = bf2f(src[(long)c0 * EVLD]);
            float vy[16];
#pragma unroll
            for (int cc = 0; cc < 16; ++cc) {
                const int c = c0 + cc;
                const bool zn = (c == 63 && lastb);
                const float xn_ld = bf2f(src[(long)(zn ? c : c + 1) * EVLD]);
                const float xnext = zn ? 0.f : xn_ld;
                const float y = silu_f(w0 * xprev + w1 * xcur + w2 * xnext);
                if (part == 0) QF[c * 132 + d] = y; else if (part == 1) KF[c * 132 + d] = y; else vy[cc] = y;
                xprev = xcur; xcur = xnext;
            }
            if (part == 2) {
                u32x4 a, b;
                a.x = cvt_pk(vy[0], vy[1]); a.y = cvt_pk(vy[2], vy[3]); a.z = cvt_pk(vy[4], vy[5]); a.w = cvt_pk(vy[6], vy[7]);
                b.x = cvt_pk(vy[8], vy[9]); b.y = cvt_pk(vy[10], vy[11]); b.z = cvt_pk(vy[12], vy[13]); b.w = cvt_pk(vy[14], vy[15]);
                bf16_t* dv = VN + ((size_t)(tb * 4 + h) * 128 + d) * 64 + c0; *(u32x4*)dv = a; *(u32x4*)(dv + 8) = b;
            }
        }
        __syncthreads();
        {
            const int row = tid >> 3, seg = tid & 7;
            LAS float* qp = QF + row * 132 + seg * 16; LAS float* kp = KF + row * 132 + seg * 16;
            float qv[16], kv[16]; float sq = 0.f, sk = 0.f;
#pragma unroll
            for (int j = 0; j < 16; ++j) { qv[j] = qp[j]; kv[j] = kp[j]; sq += qv[j] * qv[j]; sk += kv[j] * kv[j]; }
            sq += __shfl_xor(sq, 1); sq += __shfl_xor(sq, 2); sq += __shfl_xor(sq, 4);
            sk += __shfl_xor(sk, 1); sk += __shfl_xor(sk, 2); sk += __shfl_xor(sk, 4);
            const float rq = rsqrtf(sq + EPS) * SCALE, rk = rsqrtf(sk + EPS);
            u32x4 a, b;
            a.x = cvt_pk(qv[0] * rq, qv[1] * rq); a.y = cvt_pk(qv[2] * rq, qv[3] * rq); a.z = cvt_pk(qv[4] * rq, qv[5] * rq); a.w = cvt_pk(qv[6] * rq, qv[7] * rq);
            b.x = cvt_pk(qv[8] * rq, qv[9] * rq); b.y = cvt_pk(qv[10] * rq, qv[11] * rq); b.z = cvt_pk(qv[12] * rq, qv[13] * rq); b.w = cvt_pk(qv[14] * rq, qv[15] * rq);
            bf16_t* qd = QN + (size_t)(m0 + row) * 512 + h * 128 + seg * 16; *(u32x4*)qd = a; *(u32x4*)(qd + 8) = b;
#pragma unroll
            for (int j = 0; j < 16; ++j) kv[j] *= rk;
            a.x = cvt_pk(kv[0], kv[1]); a.y = cvt_pk(kv[2], kv[3]); a.z = cvt_pk(kv[4], kv[5]); a.w = cvt_pk(kv[6], kv[7]);
            b.x = cvt_pk(kv[8], kv[9]); b.y = cvt_pk(kv[10], kv[11]); b.z = cvt_pk(kv[12], kv[13]); b.w = cvt_pk(kv[14], kv[15]);
            bf16_t* kd = KN + (size_t)(m0 + row) * 512 + h * 128 + seg * 16; *(u32x4*)kd = a; *(u32x4*)(kd + 8) = b;
#pragma unroll
            for (int j = 0; j < 16; ++j) kp[j] = kv[j];
        }
        if (tid < 128) {
            const int c = tid & 63, dir = tid >> 6, m = m0 + c;
            const float bv = BG[(size_t)m * 16 + dir * 4 + h];
            const float al = BG[(size_t)m * 16 + 8 + dir * 4 + h] + p.a_dt_bias[i * 8 + dir * 4 + h];
            const float sp = al > 20.f ? al : log1pf(__expf(al));
            BETA[(size_t)(dir * 4 + h) * NTOK + m] = 1.f / (1.f + __expf(-bv));
            GG[(size_t)(dir * 4 + h) * NTOK + m] = -__expf(p.a_log[i * 8 + dir * 4 + h]) * sp;
        }
        __syncthreads();
        {
            u32x4 a, b; LAS float* kc = KF + (c0) * 132 + d;
            a.x = cvt_pk(kc[0 * 132], kc[1 * 132]); a.y = cvt_pk(kc[2 * 132], kc[3 * 132]); a.z = cvt_pk(kc[4 * 132], kc[5 * 132]); a.w = cvt_pk(kc[6 * 132], kc[7 * 132]);
            b.x = cvt_pk(kc[8 * 132], kc[9 * 132]); b.y = cvt_pk(kc[10 * 132], kc[11 * 132]); b.z = cvt_pk(kc[12 * 132], kc[13 * 132]); b.w = cvt_pk(kc[14 * 132], kc[15 * 132]);
            bf16_t* dst = KNT + ((size_t)(tb * 4 + h) * 128 + d) * 64 + c0; *(u32x4*)dst = a; *(u32x4*)(dst + 8) = b;
        }
        __syncthreads();
    }
    bf16_t* PW = (bf16_t*)(ws_ + WS_D);
    const int gw = bid * 8 + wave, NGW = G * 8;
    const int axis = lane >> 5, f = lane & 31;
    const float inv = exp2f(-(float)f * (13.287712379549449f / 32.f));
    for (int m = NPR + gw; m < NTOK; m += NGW) {
        const int t = (m - NPR) & 2047; const float pos = (float)(axis ? (t & 63) : (t >> 6));
        const float ang = pos * inv, cs = __cosf(ang), sn = __sinf(ang);
        bf16_t* base = PW + (size_t)m * EVLD + 2048 + axis * 64 + f;
#pragma unroll
        for (int hh = 0; hh < 6; ++hh) { bf16_t* q = base + hh * 128; const float x1 = bf2f(q[0]), x2 = bf2f(q[32]);
            q[0] = (bf16_t)f2bf(x1 * cs - x2 * sn); q[32] = (bf16_t)f2bf(x2 * cs + x1 * sn); }
    }
}

__device__ __forceinline__ void e3b_phase(const Params& p, unsigned char* lds_raw, int tid, int lane, int wave, int bid, int G) {
    asm volatile("" : "+s"(bid), "+s"(G), "+s"(wave));
    asm volatile("" : "+v"(tid), "+v"(lane));
    size_t zo_ = 0; asm volatile("" : "+s"(zo_)); unsigned char* ws_ = p.ws + zo_;
    const bf16_t* QN = (const bf16_t*)(ws_ + WS_QN); const bf16_t* KN = (const bf16_t*)(ws_ + WS_KN); const bf16_t* VN = (const bf16_t*)(ws_ + WS_VN);
    const float* BETA = (const float*)(ws_ + WS_BETA); const float* GG = (const float*)(ws_ + WS_G); float* GC = (float*)(ws_ + WS_GC);
    bf16_t* U = (bf16_t*)(ws_ + WS_U); bf16_t* Wb = (bf16_t*)(ws_ + WS_W); bf16_t* QK = (bf16_t*)(ws_ + WS_QK);
    const int half = wave >> 2, hw = wave & 3, ht = tid & 255;
    LAS unsigned char* lds = (LAS unsigned char*)lds_raw + half * 62464;
    const bf16_t* KNT = (const bf16_t*)(ws_ + WS_KNT);
    LAS bf16_t* KB = (LAS bf16_t*)lds;
    LAS bf16_t* QB = (LAS bf16_t*)(lds + 17408);
    LAS float* Af = (LAS float*)(lds + 34816);
    LAS float* gcl = (LAS float*)(lds + 52224);
    LAS float* betal = gcl + 64;
    u32x4 kreg[4], qreg[4];
#define E3B_LOAD(pp) do { const int it_ = 2 * (pp) + half; const int dir_ = it_ & 1, h_ = (it_ >> 1) & 3, m0_ = (it_ >> 3) * 64; \
    _Pragma("unroll") for (int j_ = 0; j_ < 4; ++j_) { const int id_ = ht + 256 * j_, c_ = id_ >> 4, seg_ = id_ & 15, tau_ = dir_ ? 63 - c_ : c_; \
        kreg[j_] = *(const u32x4*)(KN + (size_t)(m0_ + tau_) * 512 + h_ * 128 + seg_ * 8); \
        qreg[j_] = *(const u32x4*)(QN + (size_t)(m0_ + tau_) * 512 + h_ * 128 + seg_ * 8); } } while (0)
    if (bid < 768) E3B_LOAD(bid);
    for (int pit = bid; pit < 768; pit += G) {
        const int it = 2 * pit + half;
        const int dir = it & 1, h = (it >> 1) & 3, tb = it >> 3, m0 = tb * 64;
#pragma unroll
        for (int j = 0; j < 4; ++j) { const int id = ht + 256 * j, c = id >> 4, seg = id & 15;
            *(LAS u32x4*)(KB + c * 136 + seg * 8) = kreg[j];
            *(LAS u32x4*)(QB + c * 136 + seg * 8) = qreg[j]; }
        const int fr5 = lane & 15, fq5 = lane >> 4;
        const bf16_t* vb = VN + (size_t)(tb * 4 + h) * 128 * 64; const bf16_t* kb = KNT + (size_t)(tb * 4 + h) * 128 * 64;
        bf16x8 bvf[2][2], bkf[2][2];
#pragma unroll
        for (int t2 = 0; t2 < 2; ++t2)
#pragma unroll
            for (int kk = 0; kk < 2; ++kk) { const size_t o5 = (size_t)((2 * hw + t2) * 16 + fr5) * 64 + kk * 32 + fq5 * 8;
                bvf[t2][kk] = *(const bf16x8*)(vb + o5); bkf[t2][kk] = *(const bf16x8*)(kb + o5); }
        if (hw == 0) { const int tau = dir ? 63 - lane : lane; const size_t gi = (size_t)(dir * 4 + h) * NTOK + m0 + tau;
            float gv = GG[gi];
#pragma unroll
            for (int o = 1; o < 64; o <<= 1) { const float t = __shfl_up(gv, o); if (lane >= o) gv += t; }
            gcl[lane] = gv; betal[lane] = BETA[gi]; GC[gi] = gv; }
        __syncthreads();
        {
            const int fr = lane & 15, fq = lane >> 4;
#pragma unroll 1
            for (int j = 0; j < 8; ++j) {
                const int id = hw * 8 + j, mat = id >> 4, tr = (id >> 2) & 3, tc = id & 3;
                if (mat == 0 && tc > tr) continue;
                const LAS bf16_t* Ap = (mat ? QB : KB) + (tr * 16 + fr) * 136 + fq * 8;
                const LAS bf16_t* Bp = KB + (tc * 16 + fr) * 136 + fq * 8;
                f32x4 acc = {0.f, 0.f, 0.f, 0.f};
#pragma unroll
                for (int kk = 0; kk < 4; ++kk) acc = __builtin_amdgcn_mfma_f32_16x16x32_bf16(*(const LAS bf16x8*)(Ap + kk * 32), *(const LAS bf16x8*)(Bp + kk * 32), acc, 0, 0, 0);
                const int s = tc * 16 + fr; const float gs = gcl[s];
#pragma unroll
                for (int r = 0; r < 4; ++r) { const int c = tr * 16 + fq * 4 + r; const float dec = __expf(fminf(gcl[c] - gs, 0.f));
                    if (mat == 0) Af[c * 68 + s] = (s < c) ? betal[c] * acc[r] * dec : 0.f;
                    else { const int tc_ = dir ? 63 - c : c, ts_ = dir ? 63 - s : s;
                        QK[((size_t)((dir * 192 + tb) * 4 + h) * 64 + tc_) * 64 + ts_] = (bf16_t)f2bf((s <= c) ? acc[r] * dec : 0.f); } }
            }
        }
        __syncthreads();
        LAS float* Mf = (LAS float*)(lds + 17408);
        LAS bf16_t* MU = (LAS bf16_t*)lds;
        LAS float* Tm = (LAS float*)(lds + 9216);
        LAS bf16_t* MW = (LAS bf16_t*)(lds + 52736);
        if (ht < 64) {
            const int blk = ht >> 5, j = ht & 31;
            const LAS float* Ab = Af + blk * (32 * 68 + 32);
            float x[32];
#pragma unroll
            for (int r = 0; r < 32; ++r) {
                float a0 = (r == j) ? 1.f : 0.f, a1 = 0.f, a2 = 0.f, a3 = 0.f;
#pragma unroll
                for (int q = 0; q < (r + 3) / 4; ++q) { const f32x4 av = *(const LAS f32x4*)(Ab + r * 68 + 4 * q);
                    a0 -= av.x * x[4 * q];
                    if (4 * q + 1 < r) a1 -= av.y * x[4 * q + 1];
                    if (4 * q + 2 < r) a2 -= av.z * x[4 * q + 2];
                    if (4 * q + 3 < r) a3 -= av.w * x[4 * q + 3]; }
                x[r] = (a0 + a1) + (a2 + a3);
            }
            LAS float* Mb = Mf + blk * (32 * 68 + 32) + j;
#pragma unroll
            for (int r = 0; r < 32; ++r) Mb[r * 68] = x[r];
        }
        __syncthreads();
        const int br = ht >> 3, bc0 = (ht & 7) * 4;
        {
            f32x4 t = {0.f, 0.f, 0.f, 0.f};
#pragma unroll 8
            for (int q = 0; q < 32; ++q) { const float lv = Af[(32 + br) * 68 + q]; const f32x4 dvv = *(const LAS f32x4*)(Mf + q * 68 + bc0); t = t + dvv * lv; }
            *(LAS f32x4*)(Tm + br * 36 + bc0) = t;
        }
        __syncthreads();
        {
            f32x4 m = {0.f, 0.f, 0.f, 0.f};
#pragma unroll 8
            for (int q = 0; q < 32; ++q) { const float dd = Mf[(32 + br) * 68 + 32 + q]; const f32x4 tt = *(const LAS f32x4*)(Tm + q * 36 + bc0); m = m - tt * dd; }
            *(LAS f32x4*)(Mf + (32 + br) * 68 + bc0) = m;
        }
        __syncthreads();
        {
            const int c = ht >> 2, s0 = (ht & 3) * 16;
#pragma unroll
            for (int k = 0; k < 16; ++k) { const int sidx = s0 + k;
                const float mld = Mf[c * 68 + sidx]; const float m = (c < 32 && sidx >= 32) ? 0.f : mld;
                const float mu = m * betal[sidx], mw = mu * __expf(gcl[sidx]);
                const int tau = dir ? 63 - sidx : sidx;
                MU[c * 72 + tau] = (bf16_t)f2bf(mu); MW[c * 72 + tau] = (bf16_t)f2bf(mw); }
        }
        __syncthreads();
        {
            const int fr = lane & 15, fq = lane >> 4;
            float zl = 0.f; asm volatile("" : "+v"(zl));
            if (pit + G < 768) E3B_LOAD(pit + G);
#pragma unroll
            for (int t2 = 0; t2 < 2; ++t2) {
                const int jcol = (2 * hw + t2) * 16 + fr;
                bf16x8 bv[2], bk[2];
#pragma unroll
                for (int kk = 0; kk < 2; ++kk) { bv[kk] = bvf[t2][kk]; bk[kk] = bkf[t2][kk]; }
#pragma unroll 1
                for (int tr = 0; tr < 4; ++tr) {
                    f32x4 au = {0.f, 0.f, 0.f, 0.f}, aw = {0.f, 0.f, 0.f, 0.f};
#pragma unroll
                    for (int kk = 0; kk < 2; ++kk) {
                        au = __builtin_amdgcn_mfma_f32_16x16x32_bf16(*(const LAS bf16x8*)(MU + (tr * 16 + fr) * 72 + fq * 8 + kk * 32), bv[kk], au, 0, 0, 0);
                        aw = __builtin_amdgcn_mfma_f32_16x16x32_bf16(*(const LAS bf16x8*)(MW + (tr * 16 + fr) * 72 + fq * 8 + kk * 32), bk[kk], aw, 0, 0, 0); }
#pragma unroll
                    for (int r = 0; r < 4; ++r) { const int c = tr * 16 + fq * 4 + r, tauc = dir ? 63 - c : c;
                        const size_t o = ((size_t)dir * NTOK + m0 + tauc) * 512 + h * 128 + jcol;
                        U[o] = (bf16_t)f2bf(au[r] + zl); Wb[o] = (bf16_t)f2bf(aw[r] + zl); }
                }
            }
        }
        __syncthreads();
    }
}

#undef E3B_LOAD
__device__ __forceinline__ void scan_item(const Params& p, int i, int seq, int dir, int h, int sl, unsigned char* lds_raw, int tid, int lane, int wave) {
    asm volatile("" : "+s"(wave));
    asm volatile("" : "+v"(tid), "+v"(lane));
    size_t zo_ = 0; asm volatile("" : "+s"(zo_)); unsigned char* ws_ = p.ws + zo_;
    const bf16_t* QN = (const bf16_t*)(ws_ + WS_QN); const bf16_t* KNT = (const bf16_t*)(ws_ + WS_KNT);
    const bf16_t* U = (const bf16_t*)(ws_ + WS_U); const bf16_t* Wb = (const bf16_t*)(ws_ + WS_W); const bf16_t* QK = (const bf16_t*)(ws_ + WS_QK);
    const float* GC = (const float*)(ws_ + WS_GC); bf16_t* ODN = (bf16_t*)(ws_ + WS_ODN);
    LAS unsigned char* lds = (LAS unsigned char*)lds_raw;
    LAS bf16_t* Wl = (LAS bf16_t*)lds;
    LAS bf16_t* QNl = (LAS bf16_t*)(lds + 17408);
    LAS bf16_t* KTl = (LAS bf16_t*)(lds + 34816);
    LAS bf16_t* QKl = (LAS bf16_t*)(lds + 53248);
    LAS float* egc = (LAS float*)(lds + 62464);
    LAS float* egl = egc + 64;
    LAS bf16_t* ST = (LAS bf16_t*)(lds + 63488);
    LAS bf16_t* VNT = (LAS bf16_t*)(lds + 80896);
    LAS bf16_t* VNST = (LAS bf16_t*)(lds + 85504);
    const bool prompt = seq < 16;
    const int mbase = prompt ? seq * 256 : NPR + (seq - 16) * 2048, nblk = prompt ? 4 : 32;
    const int fr = lane & 15, fq = lane >> 4, tr = wave >> 1, tc = wave & 1;
    f32x4 Sacc[2];
    if (prompt) { Sacc[0] = (f32x4){0.f, 0.f, 0.f, 0.f}; Sacc[1] = Sacc[0]; }
    else { const float* s0 = p.state_a + ((size_t)(((seq - 16) * 2 + i) * 2 + dir) * 4 + h) * 16384;
#pragma unroll
        for (int eb = 0; eb < 2; ++eb)
#pragma unroll
            for (int r = 0; r < 4; ++r) Sacc[eb][r] = s0[(size_t)(wave * 16 + fq * 4 + r) * 128 + sl * 32 + eb * 16 + fr]; }
#pragma unroll
    for (int eb = 0; eb < 2; ++eb) { u32x2 w; w.x = cvt_pk(Sacc[eb][0], Sacc[eb][1]); w.y = cvt_pk(Sacc[eb][2], Sacc[eb][3]);
        *(LAS u32x2*)(ST + (eb * 16 + fr) * 136 + wave * 16 + fq * 4) = w; }
    u32x4 wreg[2], qreg[2], kreg[2], qkreg; unsigned ureg[4]; float gcv = 0.f, glast = 0.f;
#define SCAN_LOAD(n) do { const int tb_ = dir ? nblk - 1 - (n) : (n); const int m0_ = mbase + tb_ * 64; const int tbg_ = m0_ >> 6; \
    _Pragma("unroll") for (int j_ = 0; j_ < 2; ++j_) { const int id_ = tid + 512 * j_; \
        wreg[j_] = *(const u32x4*)(Wb + ((size_t)dir * NTOK + m0_ + (id_ >> 4)) * 512 + h * 128 + (id_ & 15) * 8); \
        qreg[j_] = *(const u32x4*)(QN + (size_t)(m0_ + (id_ >> 4)) * 512 + h * 128 + (id_ & 15) * 8); \
        kreg[j_] = *(const u32x4*)(KNT + ((size_t)(tbg_ * 4 + h) * 128 + (id_ >> 3)) * 64 + (id_ & 7) * 8); } \
    qkreg = *(const u32x4*)(QK + ((size_t)((dir * 192 + tbg_) * 4 + h) * 64 + (tid >> 3)) * 64 + (tid & 7) * 8); \
    _Pragma("unroll") for (int r_ = 0; r_ < 4; ++r_) ureg[r_] = U[((size_t)dir * NTOK + m0_ + tr * 16 + fq * 4 + r_) * 512 + h * 128 + sl * 32 + tc * 16 + fr]; \
    gcv = GC[(size_t)(dir * 4 + h) * NTOK + m0_ + (tid & 63)]; glast = GC[(size_t)(dir * 4 + h) * NTOK + m0_ + (dir ? 0 : 63)]; } while (0)
    SCAN_LOAD(0);
    int cur = 0;
    float zlaund = 0.f; asm volatile("" : "+v"(zlaund));
    for (int n = 0; n < nblk; ++n) {
        const int tb = dir ? nblk - 1 - n : n, m0 = mbase + tb * 64;
#pragma unroll
        for (int j = 0; j < 2; ++j) { const int id = tid + 512 * j;
            *(LAS u32x4*)(Wl + (id >> 4) * 136 + (id & 15) * 8) = wreg[j];
            *(LAS u32x4*)(QNl + (id >> 4) * 136 + (id & 15) * 8) = qreg[j];
            *(LAS u32x4*)(KTl + (id >> 3) * 72 + (id & 7) * 8) = kreg[j]; }
        *(LAS u32x4*)(QKl + (tid >> 3) * 72 + (tid & 7) * 8) = qkreg;
        if (tid < 64) { egc[tid] = __expf(gcv); egl[tid] = __expf(glast - gcv); }
        const float eg = __expf(glast);
        float uv[4];
#pragma unroll
        for (int r = 0; r < 4; ++r) uv[r] = bf2f(ureg[r]);
        __syncthreads();
        if (n + 1 < nblk) SCAN_LOAD(n + 1);
        f32x4 aws = {0.f, 0.f, 0.f, 0.f}, aqs = {0.f, 0.f, 0.f, 0.f};
        {
            const LAS bf16_t* Sp = ST + cur * (32 * 136) + (tc * 16 + fr) * 136 + fq * 8;
            const LAS bf16_t* Wp = Wl + (tr * 16 + fr) * 136 + fq * 8;
            const LAS bf16_t* Qp = QNl + (tr * 16 + fr) * 136 + fq * 8;
#pragma unroll
            for (int kk = 0; kk < 4; ++kk) { const bf16x8 sb = *(const LAS bf16x8*)(Sp + kk * 32);
                aws = __builtin_amdgcn_mfma_f32_16x16x32_bf16(*(const LAS bf16x8*)(Wp + kk * 32), sb, aws, 0, 0, 0);
                aqs = __builtin_amdgcn_mfma_f32_16x16x32_bf16(*(const LAS bf16x8*)(Qp + kk * 32), sb, aqs, 0, 0, 0); }
        }
        float vn[4], el[4], ec[4];
#pragma unroll
        for (int r = 0; r < 4; ++r) { const int c = tr * 16 + fq * 4 + r; vn[r] = uv[r] - aws[r]; el[r] = egl[c]; ec[r] = egc[c]; }
        { u32x2 w; w.x = cvt_pk(vn[0], vn[1]); w.y = cvt_pk(vn[2], vn[3]); *(LAS u32x2*)(VNT + (tc * 16 + fr) * 72 + tr * 16 + fq * 4) = w;
          w.x = cvt_pk(vn[0] * el[0], vn[1] * el[1]); w.y = cvt_pk(vn[2] * el[2], vn[3] * el[3]); *(LAS u32x2*)(VNST + (tc * 16 + fr) * 72 + tr * 16 + fq * 4) = w; }
        __syncthreads();
        {
            f32x4 ao = {0.f, 0.f, 0.f, 0.f};
            const LAS bf16_t* Ap = QKl + (tr * 16 + fr) * 72 + fq * 8;
            const LAS bf16_t* Bp = VNT + (tc * 16 + fr) * 72 + fq * 8;
#pragma unroll
            for (int kk = 0; kk < 2; ++kk) ao = __builtin_amdgcn_mfma_f32_16x16x32_bf16(*(const LAS bf16x8*)(Ap + kk * 32), *(const LAS bf16x8*)(Bp + kk * 32), ao, 0, 0, 0);
            bf16_t* od = ODN + ((size_t)dir * NTOK + m0 + tr * 16 + fq * 4) * 512 + h * 128 + sl * 32 + tc * 16 + fr;
#pragma unroll
            for (int r = 0; r < 4; ++r) od[(size_t)r * 512] = (bf16_t)f2bf(ec[r] * aqs[r] + ao[r]);
        }
        {
            const LAS bf16_t* Ap = KTl + (wave * 16 + fr) * 72 + fq * 8;
#pragma unroll
            for (int eb = 0; eb < 2; ++eb) {
                const LAS bf16_t* Bp = VNST + (eb * 16 + fr) * 72 + fq * 8;
                f32x4 a = Sacc[eb] * eg;
#pragma unroll
                for (int kk = 0; kk < 2; ++kk) a = __builtin_amdgcn_mfma_f32_16x16x32_bf16(*(const LAS bf16x8*)(Ap + kk * 32), *(const LAS bf16x8*)(Bp + kk * 32), a, 0, 0, 0);
                Sacc[eb] = a;
                const float b0 = a[0] + zlaund, b1 = a[1] + zlaund, b2 = a[2] + zlaund, b3 = a[3] + zlaund;
                u32x2 w; w.x = cvt_pk(b0, b1); w.y = cvt_pk(b2, b3);
                *(LAS u32x2*)(ST + (cur ^ 1) * (32 * 136) + (eb * 16 + fr) * 136 + wave * 16 + fq * 4) = w;
            }
        }
        cur ^= 1;
        __syncthreads();
    }
#undef SCAN_LOAD
    if (prompt) { float* so = p.out + OUT_STATE + ((size_t)((seq * 2 + i) * 2 + dir) * 4 + h) * 16384;
#pragma unroll
        for (int eb = 0; eb < 2; ++eb)
#pragma unroll
            for (int r = 0; r < 4; ++r) so[(size_t)(wave * 16 + fq * 4 + r) * 128 + sl * 32 + eb * 16 + fr] = Sacc[eb][r]; }
}

__device__ __forceinline__ void mixer_phase(const Params& p, int l, unsigned char* lds_raw, int tid, int lane, int wave, int bid, int G) {
    asm volatile("" : "+s"(bid), "+s"(G), "+s"(wave));
    size_t zo_ = 0; asm volatile("" : "+s"(zo_)); unsigned char* ws_ = p.ws + zo_;
    asm volatile("" : "+v"(tid), "+v"(lane));
    const bool even = (l & 1) == 0; const int i = l >> 1;
    const bf16_t* PROJ = (const bf16_t*)(ws_ + WS_D); bf16_t* MIX = (bf16_t*)(ws_ + WS_MIX);
    const int nitems = even ? 832 : 384;
    const int vb = (G % 8 == 0) ? (bid % 8) * (G / 8) + bid / 8 : bid;
    const bool dyn = even && G == 256;
    unsigned* qcnt = (unsigned*)p.ws + 3600 + 64 * i;
    volatile LAS unsigned* qword = (volatile LAS unsigned*)((LAS unsigned char*)lds_raw + 131072 + 64 + 16);
    for (int q = vb; q < nitems; ) {
        const int it = dyn ? (q < 128 ? 128 + q : (q < 256 ? q - 128 : q)) : q;
        int kind;
        int b = 0, hq = 0, qb = 0, seq = 0, dir = 0, hh = 0, sl = 0;
        if (even) {
            if (it < 128) { kind = 0; b = it >> 5; hq = (it >> 3) & 3; qb = it & 7; }
            else if (it < 256) { kind = 2; const int j = it - 128; sl = j & 3; hh = (j >> 2) & 3; dir = (j >> 4) & 1; seq = 16 + (j >> 5); }
            else if (it < 320) { kind = 1; const int j = it - 256; b = j >> 2; hq = j & 3; }
            else { kind = 2; const int j = it - 320; sl = j & 3; hh = (j >> 2) & 3; dir = (j >> 4) & 1; seq = j >> 5; }
        } else {
            if (it < 256) { kind = 0; b = it >> 6; hq = (it >> 3) & 7; qb = it & 7; }
            else { kind = 1; const int j = it - 256; b = j >> 3; hq = j & 7; }
        }
        if (kind == 2) scan_item(p, i, seq, dir, hh, sl, lds_raw, tid, lane, wave);
        else {
        const int ld = even ? EVLD : ODN;
        const int qcol = even ? 2048 + hq * 128 : hq * 128;
        const int kvh = even ? (hq >> 1) : (hq >> 2);
        const int kcol = even ? 2560 + kvh * 128 : 1024 + kvh * 128;
        const int vcol = even ? 2816 + kvh * 128 : 1280 + kvh * 128;
        const int ocol = even ? 512 + hq * 128 : hq * 128;
        const float m_init = even ? p.b_sink[i * 4 + hq] / SCALE : -1e30f, l_init = even ? 1.f : 0.f;
        if (kind == 1) {
            const int m0 = b * 256;
            att::attn_body<false>(PROJ + (size_t)m0 * ld + qcol, ld, nullptr, nullptr, 0, 0, PROJ + (size_t)m0 * ld + kcol, PROJ + (size_t)m0 * ld + vcol, ld, 4,
                                  MIX + (size_t)m0 * DM + ocol, DM, m_init, l_init, 0, (char*)lds_raw);
        } else {
            const int s0 = NPR + b * 2048, m0 = s0 + qb * 256;
            const bf16_t* ctx = (const bf16_t*)(ws_ + (even ? WS_CTXB : WS_CTXC)) + (size_t)((b * 2 + i) * 2) * 512 * 256 + kvh * 128;
            if (even) {
                const int loc0 = qb == 0 ? 0 : qb * 256 - 128; const int loce = qb == 7 ? 2048 : qb * 256 + 384; const int nlt = (loce - loc0) >> 6;
                att::attn_body<true>(PROJ + (size_t)m0 * ld + qcol, ld, ctx, ctx + (size_t)512 * 256, 256, 8,
                                     PROJ + (size_t)(s0 + loc0) * ld + kcol, PROJ + (size_t)(s0 + loc0) * ld + vcol, ld, 8 + nlt,
                                     MIX + (size_t)m0 * DM + ocol, DM, m_init, l_init, qb * 256 - loc0, (char*)lds_raw);
            } else {
                att::attn_body<false>(PROJ + (size_t)m0 * ld + qcol, ld, ctx, ctx + (size_t)512 * 256, 256, 8,
                                      PROJ + (size_t)s0 * ld + kcol, PROJ + (size_t)s0 * ld + vcol, ld, 40,
                                      MIX + (size_t)m0 * DM + ocol, DM, m_init, l_init, 0, (char*)lds_raw);
            }
        }
        }
        if (dyn) {
            if (tid == 0) *qword = 256u + __hip_atomic_fetch_add(qcnt, 1u, __ATOMIC_RELAXED, __HIP_MEMORY_SCOPE_AGENT);
            __syncthreads();
            q = (int)*qword;
            __syncthreads();
        } else q += G;
    }
}

__device__ __forceinline__ void e5_phase(const Params& p, int i, int gw, int NGW, int lane) {
    asm volatile("" : "+s"(gw), "+s"(NGW));
    size_t zo_ = 0; asm volatile("" : "+s"(zo_)); unsigned char* ws_ = p.ws + zo_;
    asm volatile("" : "+v"(lane));
    const bf16_t* ODN = (const bf16_t*)(ws_ + WS_ODN); const bf16_t* PROJ = (const bf16_t*)(ws_ + WS_D); bf16_t* MIX = (bf16_t*)(ws_ + WS_MIX);
    const float* ng = p.a_norm_g + i * 128 + (lane & 15) * 8;
    const f32x4 g0 = *(const f32x4*)ng, g1 = *(const f32x4*)(ng + 4);
    for (int m = gw; m < NTOK; m += NGW) {
        const u32x4 a = *(const u32x4*)(ODN + (size_t)m * 512 + lane * 8), b = *(const u32x4*)(ODN + ((size_t)NTOK + m) * 512 + lane * 8);
        const u32x4 gt = *(const u32x4*)(PROJ + (size_t)m * EVLD + 1536 + lane * 8);
        float o[8], gv[8];
        o[0] = bflo(a.x) + bflo(b.x); o[1] = bfhi(a.x) + bfhi(b.x); o[2] = bflo(a.y) + bflo(b.y); o[3] = bfhi(a.y) + bfhi(b.y);
        o[4] = bflo(a.z) + bflo(b.z); o[5] = bfhi(a.z) + bfhi(b.z); o[6] = bflo(a.w) + bflo(b.w); o[7] = bfhi(a.w) + bfhi(b.w);
        gv[0] = bflo(gt.x); gv[1] = bfhi(gt.x); gv[2] = bflo(gt.y); gv[3] = bfhi(gt.y); gv[4] = bflo(gt.z); gv[5] = bfhi(gt.z); gv[6] = bflo(gt.w); gv[7] = bfhi(gt.w);
        float ss = 0.f;
#pragma unroll
        for (int j = 0; j < 8; ++j) ss += o[j] * o[j];
        ss += __shfl_xor(ss, 1); ss += __shfl_xor(ss, 2); ss += __shfl_xor(ss, 4); ss += __shfl_xor(ss, 8);
        const float rstd = rsqrtf(ss * (1.f / 128.f) + EPS);
        float y[8];
#pragma unroll
        for (int j = 0; j < 8; ++j) y[j] = o[j] * rstd * (j < 4 ? g0[j] : g1[j - 4]) * silu_f(gv[j]);
        u32x4 w; w.x = cvt_pk(y[0], y[1]); w.y = cvt_pk(y[2], y[3]); w.z = cvt_pk(y[4], y[5]); w.w = cvt_pk(y[6], y[7]);
        *(u32x4*)(MIX + (size_t)m * DM + lane * 8) = w;
    }
}

__device__ __forceinline__ void o3_phase(const Params& p, int i, int gw, int NGW, int lane) {
    asm volatile("" : "+s"(gw), "+s"(NGW));
    asm volatile("" : "+v"(lane));
    size_t zo_ = 0; asm volatile("" : "+s"(zo_)); unsigned char* ws_ = p.ws + zo_;
    bf16_t* PW = (bf16_t*)(ws_ + WS_D);
    const int cq = lane & 15, hl = lane >> 4, axis = cq >> 3, d0 = cq * 8; const bool hihalf = ((cq >> 2) & 1) != 0;
    float inv[8];
#pragma unroll
    for (int j = 0; j < 8; ++j) inv[j] = exp2f(-(float)((cq & 3) * 8 + j) * (13.287712379549449f / 32.f));
    const float* gqp = p.c_qnorm_g + i * 128 + d0; const float* gkp = p.c_knorm_g + i * 128 + d0;
    const f32x4 gq0 = *(const f32x4*)gqp, gq1 = *(const f32x4*)(gqp + 4), gk0 = *(const f32x4*)gkp, gk1 = *(const f32x4*)(gkp + 4);
    for (int m = gw; m < NTOK; m += NGW) {
        const bool smp = m >= NPR;
        float cs[8], sn[8];
        if (smp) { const int t = (m - NPR) & 2047; const float pos = (float)(axis ? (t & 63) : (t >> 6));
#pragma unroll
            for (int j = 0; j < 8; ++j) { const float ang = pos * inv[j]; cs[j] = __cosf(ang); sn[j] = __sinf(ang); } }
        else {
#pragma unroll
            for (int j = 0; j < 8; ++j) { cs[j] = 1.f; sn[j] = 0.f; } }
        bf16_t* row = PW + (size_t)m * ODN;
#pragma unroll
        for (int pass = 0; pass < 3; ++pass) {
            const int hh = pass * 4 + hl; const bool act = hh < 10; const int hc = act ? hh : 9;
            bf16_t* q = row + hc * 128 + d0;
            const u32x4 xv = *(const u32x4*)q;
            float x[8];
            x[0] = bflo(xv.x); x[1] = bfhi(xv.x); x[2] = bflo(xv.y); x[3] = bfhi(xv.y); x[4] = bflo(xv.z); x[5] = bfhi(xv.z); x[6] = bflo(xv.w); x[7] = bfhi(xv.w);
            float ss = 0.f;
#pragma unroll
            for (int j = 0; j < 8; ++j) ss += x[j] * x[j];
            ss += __shfl_xor(ss, 1); ss += __shfl_xor(ss, 2); ss += __shfl_xor(ss, 4); ss += __shfl_xor(ss, 8);
            const float rstd = rsqrtf(ss * (1.f / 128.f) + EPS);
            const bool isk = hc >= 8;
            float y[8], o[8];
#pragma unroll
            for (int j = 0; j < 4; ++j) { y[j] = x[j] * rstd * (isk ? gk0[j] : gq0[j]); y[4 + j] = x[4 + j] * rstd * (isk ? gk1[j] : gq1[j]); }
            if (!smp && act && isk) { float* co = p.out + OUT_CC + ((size_t)(((m >> 8) * 2 + i) * 2) * 256 + (m & 255)) * 256 + (hc - 8) * 128 + d0;
                *(f32x4*)co = (f32x4){y[0], y[1], y[2], y[3]}; *(f32x4*)(co + 4) = (f32x4){y[4], y[5], y[6], y[7]}; }
#pragma unroll
            for (int j = 0; j < 8; ++j) { const float yp = __shfl_xor(y[j], 4); o[j] = hihalf ? y[j] * cs[j] + yp * sn[j] : y[j] * cs[j] - yp * sn[j]; }
            if (act) { u32x4 w; w.x = cvt_pk(o[0], o[1]); w.y = cvt_pk(o[2], o[3]); w.z = cvt_pk(o[4], o[5]); w.w = cvt_pk(o[6], o[7]); *(u32x4*)q = w; }
        }
    }
}


#define XB_TMO      128
#define XB_XCNT(j)  (256  + 64 * (j))
#define XB_XSUB(j)  (1280 + 64 * (j))
#define XB_XGEN(j)  (2304 + 64 * (j))
#define XB_TOP      3328
#define XB_TOPGEN   3392
#define XCD_BAR_WORDS 3456
#define XB_SPIN_CAP (1u << 18)
__device__ __forceinline__ unsigned xb_ld(unsigned* p)              { return __hip_atomic_load(p, __ATOMIC_RELAXED, __HIP_MEMORY_SCOPE_AGENT); }
__device__ __forceinline__ unsigned xb_add(unsigned* p, unsigned v) { return __hip_atomic_fetch_add(p, v, __ATOMIC_RELAXED, __HIP_MEMORY_SCOPE_AGENT); }
__device__ __forceinline__ unsigned xb_xcc_id() { return (unsigned)__builtin_amdgcn_s_getreg((3 << 11) | 20) & 0xFu; }
#define XB_SPIN(cond, bar) do { unsigned _sp = 0; while (cond) { __builtin_amdgcn_s_sleep(1); \
    if ((++_sp & 255u) == 0u) { if (xb_ld(&(bar)[XB_TMO])) break; if (_sp > XB_SPIN_CAP) { atomicAdd(&(bar)[XB_TMO], 1u); break; } } } } while (0)
struct XcdBarrier { unsigned* bar; unsigned x; volatile LAS unsigned* st; };
__device__ __forceinline__ XcdBarrier xcd_barrier_post(unsigned* bar, volatile LAS unsigned* st) {
    XcdBarrier b; b.bar = bar; b.x = xb_xcc_id(); b.st = st;
    if (threadIdx.x == 0) (void)xb_add(&bar[XB_XCNT(b.x)], 1u);
    return b;
}
__device__ __forceinline__ void xcd_barrier_complete(unsigned* bar, unsigned x, unsigned& nloc, unsigned& nx) {
    const unsigned G = gridDim.x * gridDim.y * gridDim.z;
    unsigned sum, cnt, mine, sp = 0u;
    for (;;) {
        sum = 0u; cnt = 0u; mine = 0u;
#pragma unroll
        for (unsigned j = 0; j < 16; ++j) { const unsigned c = xb_ld(&bar[XB_XCNT(j)]); sum += c; cnt += (c > 0u) ? 1u : 0u; mine = (j == x) ? c : mine; }
        if (sum == G) break;
        __builtin_amdgcn_s_sleep(1);
        if ((++sp & 255u) == 0u) { if (xb_ld(&bar[XB_TMO])) break; if (sp > XB_SPIN_CAP) { atomicAdd(&bar[XB_TMO], 1u); break; } }
    }
    nloc = mine > 0u ? mine : 1u; nx = cnt > 0u ? cnt : 1u;
}
__device__ __forceinline__ void xcd_barrier(const XcdBarrier& b) {
    asm volatile("s_waitcnt vmcnt(0)" ::: "memory");
    __syncthreads();
    if (threadIdx.x == 0) {
        unsigned* bar = b.bar;
        __builtin_amdgcn_s_waitcnt(0);
        unsigned nloc = b.st[0], nx = b.st[1];
        if (nloc == 0u) { xcd_barrier_complete(bar, b.x, nloc, nx); b.st[0] = nloc; b.st[1] = nx; }
        const unsigned old = xb_add(&bar[XB_XSUB(b.x)], 1u);
        const unsigned gen = old / nloc;
        if (old + 1u == (gen + 1u) * nloc) {
            __builtin_amdgcn_fence(__ATOMIC_RELEASE, "agent");
            asm volatile("s_waitcnt vmcnt(0)" ::: "memory");
            const unsigned og = xb_add(&bar[XB_TOP], 1u);
            const unsigned tg = og / nx;
            if (og + 1u == (tg + 1u) * nx) xb_add(&bar[XB_TOPGEN], 1u);
            else XB_SPIN(xb_ld(&bar[XB_TOPGEN]) == tg, bar);
            __builtin_amdgcn_fence(__ATOMIC_ACQUIRE, "agent");
            xb_add(&bar[XB_XGEN(b.x)], 1u);
            asm volatile("s_waitcnt vmcnt(0)" ::: "memory");
        } else {
            XB_SPIN(xb_ld(&bar[XB_XGEN(b.x)]) == gen, bar);
            __builtin_amdgcn_fence(__ATOMIC_ACQUIRE, "agent");
            asm volatile("s_waitcnt vmcnt(0)" ::: "memory");
        }
    }
    __syncthreads();
}
__global__ void __launch_bounds__(512, 2) mega_fwd(Params p) {
    extern __shared__ __attribute__((aligned(16))) unsigned char lds_raw[];
    cg::grid_group grid = cg::this_grid();
#define GSYNC() do { asm volatile("s_waitcnt vmcnt(0) lgkmcnt(0)" ::: "memory"); grid.sync(); __builtin_amdgcn_fence(__ATOMIC_ACQUIRE, "agent"); asm volatile("s_waitcnt vmcnt(0)" ::: "memory"); } while (0)
    const int tid = threadIdx.x, lane = tid & 63, wave = __builtin_amdgcn_readfirstlane(tid >> 6);
    const int G = gridDim.x, bid = blockIdx.x, gw = bid * 8 + wave, NGW = G * 8;

    volatile LAS unsigned* misc = (volatile LAS unsigned*)((LAS unsigned char*)lds_raw + 131072 + 64);
    if (tid == 0) { misc[0] = 0u; misc[1] = 0u; }
    __syncthreads();
    (void)xcd_barrier_post((unsigned*)p.ws, misc);
    phase0(p, lds_raw, tid, lane, wave, bid, G);
#define XSYNC() do { XcdBarrier xb_; xb_.bar = (unsigned*)p.ws; xb_.x = xb_xcc_id(); xb_.st = (volatile LAS unsigned*)((LAS unsigned char*)lds_raw + 131072 + 64); xcd_barrier(xb_); } while (0)
    if (p.ws == nullptr) GSYNC();
    XSYNC();
#pragma unroll 1
    for (int l = 0; l < NLAYERS; ++l) {
        const bool even = (l & 1) == 0; const int i = l >> 1;
        size_t zo = 0; asm volatile("" : "+s"(zo)); unsigned char* ws = p.ws + zo; float* X = p.out + zo;
        bf16_t* H = (bf16_t*)(ws + WS_H); bf16_t* MIX = (bf16_t*)(ws + WS_MIX); bf16_t* DBUF = (bf16_t*)(ws + WS_D);
        const float* modl = (const float*)(ws + WS_MOD) + (size_t)l * 5 * 6144;
        bf16_t* X16 = (bf16_t*)(ws + WS_X16);
        if (l == 0) norm_phase(p.x_prompt, p.x_sample, nullptr, p.norm1_g, modl, 0, 1, H, gw, NGW, lane);
        else norm16_phase(X16, p.norm1_g + l * DM, modl, 0, 1, H, gw, NGW, lane);
        XSYNC();
        {
            const int N = even ? EVN : ODN;
            const bf16_t* Wt = even ? (const bf16_t*)(ws + WS_WEVIN) + (size_t)i * EVN * 1024 : (const bf16_t*)(ws + WS_WODIN) + (size_t)i * ODN * 1024;
            pg8::Gemm g{H, Wt, NTOK, N, DM}; pg8::StaticOrder S; S.init(NTOK, N, G, bid);
            pg8::EpiProj E;
            E.O = DBUF; E.ldc = even ? EVLD : ODN; E.npn_store = even ? 12 : 6;
            E.cache = X + (even ? OUT_CB : OUT_CC) + (size_t)i * 2 * 65536; E.pn_k = even ? 10 : 4; E.pn_lo = even ? 10 : 5; E.pn_hi = even ? 12 : 6;
            E.bg = (float*)(ws + WS_BG); E.pn_bg = even ? 12 : -1;
            pg8::gemm_phase<pg8::EpiProj>((LAS unsigned char*)lds_raw, g, S, E);
        }
        XSYNC();
        if (even) {
            e3a_phase(p, i, lds_raw, tid, lane, wave, bid, G);
            XSYNC();
            e3b_phase(p, lds_raw, tid, lane, wave, bid, G);
            XSYNC();
        } else {
            o3_phase(p, i, gw, NGW, lane);
            XSYNC();
        }
        mixer_phase(p, l, lds_raw, tid, lane, wave, bid, G);
        XSYNC();
        if (even) { e5_phase(p, i, gw, NGW, lane); XSYNC(); }
        {
            const bf16_t* Wt = even ? (const bf16_t*)(ws + WS_WEVOUT) + (size_t)i * 1024 * 1024 : (const bf16_t*)(ws + WS_WODOUT) + (size_t)i * 1024 * 1024;
            pg8::Gemm g{MIX, Wt, NTOK, DM, DM}; pg8::StaticOrder S; S.init(NTOK, DM, G, bid);
            pg8::EpiResid E; E.X = X16; E.gate = modl + 2 * 1024; E.xin_p = l == 0 ? p.x_prompt : nullptr; E.xin_s = l == 0 ? p.x_sample : nullptr;
            pg8::gemm_phase<pg8::EpiResid>((LAS unsigned char*)lds_raw, g, S, E);
        }
        XSYNC();
        norm16_phase(X16, p.norm2_g + l * DM, modl, 3, 4, H, gw, NGW, lane);
        XSYNC();
        {
            pg8::Gemm g{H, (const bf16_t*)(ws + WS_W1) + (size_t)l * DFF * DM, NTOK, DFF, DM}; pg8::StaticOrder S; S.init(NTOK, DFF, G, bid);
            pg8::EpiAct E; E.O = DBUF; E.ldc = DFF;
            pg8::gemm_phase<pg8::EpiAct>((LAS unsigned char*)lds_raw, g, S, E);
        }
        XSYNC();
        {
            pg8::Gemm g{DBUF, (const bf16_t*)(ws + WS_W2) + (size_t)l * DM * DFF, NTOK, DM, DFF}; pg8::StaticOrder S; S.init(NTOK, DM, G, bid);
            pg8::EpiResid E; E.X = X16; E.gate = modl + 5 * 1024; E.xin_p = nullptr; E.xin_s = nullptr;
            pg8::gemm_phase<pg8::EpiResid>((LAS unsigned char*)lds_raw, g, S, E);
        }
        XSYNC();
    }
    final_phase((const bf16_t*)(p.ws + WS_X16), p.out, p.final_g, gw, NGW, lane);
}

extern "C" void kernel_launch(void* const* d_in, const int* in_sizes, int n_in, void* d_out, int out_size, void* d_ws, size_t ws_size, hipStream_t stream) {
    static int grid = 0;
    if (grid == 0) {
        if (n_in != 25 || out_size != 25165824 || ws_size < WS_END) { fprintf(stderr, "kernel_launch: unexpected shapes: n_in %d out %d ws %zu\n", n_in, out_size, ws_size); grid = -1; return; }
        int dev = 0, cus = 0, per_cu = 0;
        hipGetDevice(&dev);
        hipDeviceGetAttribute(&cus, hipDeviceAttributeMultiprocessorCount, dev);
        if (hipFuncSetAttribute((const void*)mega_fwd, hipFuncAttributeMaxDynamicSharedMemorySize, LDS_BYTES) != hipSuccess) { fprintf(stderr, "kernel_launch: hipFuncSetAttribute failed\n"); grid = -1; return; }
        if (hipOccupancyMaxActiveBlocksPerMultiprocessor(&per_cu, (const void*)mega_fwd, 512, LDS_BYTES) != hipSuccess || per_cu < 1) { fprintf(stderr, "kernel_launch: occupancy query says %d\n", per_cu); per_cu = 1; }
        (void)hipGetLastError();
        grid = cus * 1;
    }
    if (grid < 0) return;
    if (hipMemsetAsync(d_ws, 0, 16384, stream) != hipSuccess) { fprintf(stderr, "kernel_launch: memset failed\n"); return; }
    Params p{};
    const float** pp = (const float**)&p;
    for (int k = 0; k < 25; ++k) pp[k] = (const float*)d_in[k];
    p.out = (float*)d_out; p.ws = (unsigned char*)d_ws;
    void* args[] = {&p};
    hipError_t e = hipLaunchCooperativeKernel((const void*)mega_fwd, dim3(grid), dim3(512), args, LDS_BYTES, stream);
    if (e != hipSuccess) fprintf(stderr, "kernel_launch: cooperative launch failed: %s (grid %d)\n", hipGetErrorString(e), grid);
}
```
